# Optimizing an MI355X kernel written in HIP

```python
import jax, jax.numpy as jnp
from jax import lax
import numpy as np

D_MODEL = 1024
BATCH = 16
SEQ = 2048
DEPTH = 1

MLA_HEADS = 8
MLA_Q_RANK = 384
MLA_KV_RANK = 256
MLA_NOPE = 64
MLA_ROPE = 32
MLA_V = 64
MLA_WIDTH = MLA_HEADS * MLA_V
ROPE_THETA = 10000.0
Q_BLOCK = 128

GLA_HEADS = 4
GLA_HEAD_K = 64
GLA_HEAD_V = 128
GLA_DK = GLA_HEADS * GLA_HEAD_K
GLA_DV = GLA_HEADS * GLA_HEAD_V
GLA_GATE_RANK = 16
GLA_GATE_NORMALIZER = 16.0
GLA_CHUNK = 64

PLE_DIM = 256

EPS = 1e-6

IN_SPLITS = (
    MLA_Q_RANK,
    MLA_KV_RANK,
    MLA_ROPE,
    MLA_WIDTH,
    GLA_DK,
    GLA_DK,
    GLA_DV,
    GLA_GATE_RANK,
    GLA_DV,
    D_MODEL,
    D_MODEL,
)
IN_WIDTH = sum(IN_SPLITS)

kernel_name = 'hybrid_mla_gla_gated_merge_ple'


def rmsnorm(x, g):
    xf = x.astype(jnp.float32)
    y = xf * lax.rsqrt(jnp.mean(xf * xf, axis=-1, keepdims=True) + EPS)
    return (y * g.astype(jnp.float32)).astype(x.dtype)


def rope(x, pos):
    r = x.shape[-1]
    inv_freq = 1.0 / (ROPE_THETA ** (jnp.arange(0, r, 2, dtype=jnp.float32) / r))
    ang = pos.astype(jnp.float32)[..., None] * inv_freq
    cos = jnp.cos(ang)[:, :, None, :]
    sin = jnp.sin(ang)[:, :, None, :]
    xf = x.astype(jnp.float32)
    x1, x2 = jnp.split(xf, 2, axis=-1)
    out = jnp.concatenate([x1 * cos - x2 * sin, x2 * cos + x1 * sin], axis=-1)
    return out.astype(x.dtype)


def mla_attention(q_nope, q_rope, k_nope, k_rope, v):
    b, s, h, _ = q_nope.shape
    nb = s // Q_BLOCK
    scale = (MLA_NOPE + MLA_ROPE) ** -0.5
    qn = q_nope.reshape(b, nb, Q_BLOCK, h, MLA_NOPE).transpose(1, 0, 2, 3, 4)
    qr = q_rope.reshape(b, nb, Q_BLOCK, h, MLA_ROPE).transpose(1, 0, 2, 3, 4)
    kpos = jnp.arange(s)

    def block(args):
        qn_i, qr_i, i = args
        sc = (jnp.einsum('bqhd,bkhd->bhqk', qn_i, k_nope).astype(jnp.float32)
              + jnp.einsum('bqhr,bkr->bhqk', qr_i, k_rope).astype(jnp.float32)) * scale
        qpos = i * Q_BLOCK + jnp.arange(Q_BLOCK)
        mask = kpos[None, :] <= qpos[:, None]
        sc = jnp.where(mask[None, None], sc, -jnp.inf)
        pr = jax.nn.softmax(sc, axis=-1).astype(v.dtype)
        return jnp.einsum('bhqk,bkhd->bqhd', pr, v)

    o = lax.map(block, (qn, qr, jnp.arange(nb)))
    return o.transpose(1, 0, 2, 3, 4).reshape(b, s, h, MLA_V)


def gla_chunked(q, k, v, g):
    b, s, h, dk = q.shape
    dv = v.shape[-1]
    c = GLA_CHUNK
    n = s // c

    def to_chunks(t):
        return t.astype(jnp.float32).reshape(b, n, c, h, t.shape[-1]).transpose(1, 0, 3, 2, 4)

    qc = to_chunks(q) * (dk ** -0.5)
    kc = to_chunks(k)
    vc = to_chunks(v)
    bc = jnp.cumsum(to_chunks(g), axis=3)
    causal = jnp.tril(jnp.ones((c, c), dtype=bool))

    def step(state, inp):
        qi, ki, vi, bi = inp
        o_inter = jnp.einsum('bhcd,bhde->bhce', qi * jnp.exp(bi), state)
        diff = bi[:, :, :, None, :] - bi[:, :, None, :, :]
        decay = jnp.exp(jnp.where(causal[None, None, :, :, None], diff, -jnp.inf))
        attn = jnp.einsum('bhid,bhjd,bhijd->bhij', qi, ki, decay)
        o = o_inter + jnp.einsum('bhij,bhje->bhie', attn, vi)
        b_last = bi[:, :, -1:, :]
        k_dec = ki * jnp.exp(b_last - bi)
        state = (state * jnp.exp(b_last[:, :, 0, :])[..., None]
                 + jnp.einsum('bhcd,bhce->bhde', k_dec, vi))
        return state, o

    s0 = jnp.zeros((b, h, dk, dv), jnp.float32)
    _, o = lax.scan(step, s0, (qc, kc, vc, bc))
    return o.transpose(1, 0, 3, 2, 4).reshape(b, s, h, dv)


def split_in(proj):
    offsets = [int(o) for o in np.cumsum(IN_SPLITS)[:-1]]
    return jnp.split(proj, offsets, axis=-1)


def setup_inputs(seed: int = 0) -> dict:
    key = jax.random.key(seed)
    ks = jax.random.split(key, 24)
    f32 = jnp.float32

    def w(k, shape, fan_in):
        return jax.random.normal(k, shape, f32) * (fan_in ** -0.5)

    def gain(k, shape):
        return 1.0 + 0.02 * jax.random.normal(k, shape, f32)

    x = jax.random.normal(ks[0], (BATCH, SEQ, D_MODEL), f32)
    p = jax.random.normal(ks[1], (DEPTH, BATCH, SEQ, PLE_DIM), f32)
    offs = jax.random.randint(ks[2], (BATCH, 1), 0, 4096, dtype=jnp.int32)
    positions = offs + jnp.arange(SEQ, dtype=jnp.int32)[None, :]
    return {
        'x': x,
        'p': p,
        'positions': positions,
        'norm_in_g': gain(ks[3], (DEPTH, D_MODEL)),
        'w_in': w(ks[4], (DEPTH, D_MODEL, IN_WIDTH), D_MODEL),
        'q_norm_g': gain(ks[5], (DEPTH, MLA_Q_RANK)),
        'w_uq': w(ks[6], (DEPTH, MLA_Q_RANK, MLA_HEADS * (MLA_NOPE + MLA_ROPE)), MLA_Q_RANK),
        'kv_norm_g': gain(ks[7], (DEPTH, MLA_KV_RANK)),
        'w_ukv': w(ks[8], (DEPTH, MLA_KV_RANK, MLA_HEADS * (MLA_NOPE + MLA_V)), MLA_KV_RANK),
        'w_gk_up': w(ks[9], (DEPTH, GLA_GATE_RANK, GLA_DK), GLA_GATE_RANK),
        'b_gk': 0.1 * jax.random.normal(ks[10], (DEPTH, GLA_DK), f32),
        'gla_norm_g': gain(ks[11], (DEPTH, GLA_HEAD_V)),
        'w_mla_br': w(ks[12], (DEPTH, MLA_WIDTH, D_MODEL), MLA_WIDTH),
        'w_gla_br': w(ks[13], (DEPTH, GLA_DV, D_MODEL), GLA_DV),
        'w_out': w(ks[14], (DEPTH, D_MODEL, D_MODEL), D_MODEL),
        'w_ple': w(ks[15], (DEPTH, PLE_DIM, D_MODEL), PLE_DIM),
        'ple_norm_g': gain(ks[16], (DEPTH, D_MODEL)),
        'ple_gate_norm_g': gain(ks[17], (DEPTH, D_MODEL)),
        'w_ple_gate': w(ks[18], (DEPTH, D_MODEL, D_MODEL), D_MODEL),
        'final_norm_g': gain(ks[19], (D_MODEL,)),
    }


def reference(x, p, positions, norm_in_g, w_in, q_norm_g, w_uq, kv_norm_g, w_ukv,
              w_gk_up, b_gk, gla_norm_g, w_mla_br, w_gla_br, w_out, w_ple, ple_norm_g,
              ple_gate_norm_g, w_ple_gate, final_norm_g):
    b, s, _ = x.shape
    for l in range(DEPTH):
        h = rmsnorm(x, norm_in_g[l])
        proj = h @ w_in[l]
        (cq, ckv, kr, gate_mla, gq, gk, gv, gk_low, gate_gla,
         merge_a, merge_b) = split_in(proj)

        cq = rmsnorm(cq, q_norm_g[l])
        q = (cq @ w_uq[l]).reshape(b, s, MLA_HEADS, MLA_NOPE + MLA_ROPE)
        q_nope, q_rope = q[..., :MLA_NOPE], q[..., MLA_NOPE:]
        q_rope = rope(q_rope, positions)
        ckv = rmsnorm(ckv, kv_norm_g[l])
        kv = (ckv @ w_ukv[l]).reshape(b, s, MLA_HEADS, MLA_NOPE + MLA_V)
        k_nope, v_mla = kv[..., :MLA_NOPE], kv[..., MLA_NOPE:]
        k_rope = rope(kr[:, :, None, :], positions)[:, :, 0, :]
        o_mla = mla_attention(q_nope, q_rope, k_nope, k_rope, v_mla).reshape(b, s, MLA_WIDTH)
        y_a = (o_mla * jax.nn.silu(gate_mla)) @ w_mla_br[l]

        qg = gq.reshape(b, s, GLA_HEADS, GLA_HEAD_K)
        kg = gk.reshape(b, s, GLA_HEADS, GLA_HEAD_K)
        vg = gv.reshape(b, s, GLA_HEADS, GLA_HEAD_V)
        log_a = jax.nn.log_sigmoid((gk_low @ w_gk_up[l] + b_gk[l]).astype(jnp.float32)) / GLA_GATE_NORMALIZER
        log_a = log_a.reshape(b, s, GLA_HEADS, GLA_HEAD_K)
        o_gla = gla_chunked(qg, kg, vg, log_a).astype(x.dtype)
        o_gla = rmsnorm(o_gla, gla_norm_g[l]).reshape(b, s, GLA_DV)
        y_b = (o_gla * jax.nn.silu(gate_gla)) @ w_gla_br[l]

        merged = jax.nn.sigmoid(merge_a) * y_a + jax.nn.sigmoid(merge_b) * y_b
        x = x + merged @ w_out[l]

        e = rmsnorm(p[l] @ w_ple[l], ple_norm_g[l])
        g_ple = jax.nn.sigmoid(rmsnorm(x, ple_gate_norm_g[l]) @ w_ple_gate[l])
        x = x + g_ple * e
    return rmsnorm(x, final_norm_g)
```

```cpp
#include <hip/hip_runtime.h>
#include <hip/hip_bf16.h>
#include <cstdio>
#include <cstdint>
#include <cmath>

#define LAS __attribute__((address_space(3)))
#define GAS __attribute__((address_space(1)))
typedef unsigned short bf16_t;
typedef short bf16x8 __attribute__((ext_vector_type(8)));
typedef short s16x4 __attribute__((ext_vector_type(4)));
typedef float f32x4 __attribute__((ext_vector_type(4)));
typedef float f32x16 __attribute__((ext_vector_type(16)));
typedef unsigned u32x4 __attribute__((ext_vector_type(4)));
typedef unsigned u32x2 __attribute__((ext_vector_type(2)));

constexpr int NB = 16, SEQ = 2048, M = NB * SEQ, D = 1024;
constexpr int NIN = 4864;
constexpr int NIN_REAL = 4784;
constexpr float EPS = 1e-6f;
constexpr float LOG2E = 1.4426950408889634f;
constexpr float C2Q = 0.10206207261596577f * LOG2E;

__device__ __forceinline__ unsigned cvt_pk_bf16(float lo, float hi) { unsigned r; asm volatile("v_cvt_pk_bf16_f32 %0, %1, %2" : "=v"(r) : "v"(lo), "v"(hi)); return r; }
__device__ __forceinline__ float bflo(unsigned w) { return __uint_as_float(w << 16); }
__device__ __forceinline__ float bfhi(unsigned w) { return __uint_as_float(w & 0xffff0000u); }
__device__ __forceinline__ float bf1(bf16_t b) { return __uint_as_float((unsigned)b << 16); }
__device__ __forceinline__ float sigm(float x) { return __builtin_amdgcn_rcpf(1.f + __builtin_amdgcn_exp2f(-LOG2E * x)); }
__device__ __forceinline__ float rsq(float x) { return __builtin_amdgcn_rsqf(x); }

namespace pg8 {
constexpr int BM = 256, BK = 64, HALF = 128, HTB = HALF * BK * 2, STAGE_BYTES = 8 * HTB, NXCD = 8, WGM = 8;
__host__ __device__ __forceinline__ int lds_byte(int r, int c) { const int st = (r >> 4) * 2 + (c >> 5), rr = r & 15, cc = c & 31, ob = rr * 64 + cc * 2; return st * 1024 + (ob ^ (((ob >> 9) & 1) << 5)); }
__host__ __device__ __forceinline__ void stage_rc(int b, int& R, int& C) { const int st = b / 1024, sb = b % 1024, swz = sb ^ (((sb >> 9) & 1) << 5); R = (st >> 1) * 16 + swz / 64; C = (st & 1) * 32 + (swz % 64) / 2; }
__host__ __device__ __forceinline__ int perm32(int rho) { const int n = rho >> 4, i = rho & 15; return 8 * (i >> 2) + 4 * n + (i & 3); }

struct Unit { int pm, pn; };
struct Gemm { const bf16_t* A; const bf16_t* Bt; int M, N, K, lda; };

struct StaticOrder {
    int nM, nN, nwg, G, c;
    __host__ __device__ void init(int M_, int N_, int G_, int c_) { nM = M_ / BM; nN = N_ / BM; nwg = nM * nN; G = G_; c = c_; }
    __host__ __device__ bool next(int i, Unit& u) const {
        const long L = (long)i * G + c; if (L >= nwg) return false;
        int wgid = (int)L; { const int q = nwg / NXCD, r = nwg % NXCD, xcd = wgid % NXCD, off = wgid / NXCD; wgid = (xcd < r ? xcd * (q + 1) : r * (q + 1) + (xcd - r) * q) + off; }
        const int nig = WGM * nN, gid = wgid / nig, fm = gid * WGM, gsz = (nM - fm) < WGM ? (nM - fm) : WGM;
        u.pm = fm + ((wgid % nig) % gsz); u.pn = (wgid % nig) / gsz; return true;
    }
};

typedef f32x4 Acc[2][2][4][2];

__device__ __forceinline__ float sum8sq(const f32x4& a, const f32x4& b) { return (a[0] * a[0] + a[1] * a[1]) + (a[2] * a[2] + a[3] * a[3]) + (b[0] * b[0] + b[1] * b[1]) + (b[2] * b[2] + b[3] * b[3]); }
__device__ __forceinline__ float red_fq(float s) { s += __shfl_xor(s, 16); s += __shfl_xor(s, 32); return s; }
__device__ __forceinline__ u32x4 pack8(const f32x4& a, const f32x4& b) { u32x4 w; w.x = cvt_pk_bf16(a[0], a[1]); w.y = cvt_pk_bf16(a[2], a[3]); w.z = cvt_pk_bf16(b[0], b[1]); w.w = cvt_pk_bf16(b[2], b[3]); return w; }

struct EpiProj {
    static constexpr bool PERM = true, HAS_MID = false;
    bf16_t *cq, *ckv, *gq, *gk, *gv, *acat, *sma, *smb, *small; float* ssqa; const float* rope;
    __device__ __forceinline__ void mid(Acc&, const Unit&, int, int, int, int) const {}
    __device__ __forceinline__ void operator()(const Acc& acc, const Unit& u, int wr, int wc, int fr, int fq) const {
#pragma unroll
        for (int bj = 0; bj < 2; ++bj) {
            const int hb = 2 * u.pn + bj;
            bf16_t* dst; int ldc, coff, act = 0;
            if (hb < 3) { dst = cq; ldc = 384; coff = hb * 128; }
            else if (hb < 5) { dst = ckv; ldc = 256; coff = (hb - 3) * 128; }
            else if (hb < 7) { dst = gq; ldc = 256; coff = (hb - 5) * 128; }
            else if (hb < 9) { dst = gk; ldc = 256; coff = (hb - 7) * 128; }
            else if (hb < 13) { dst = gv; ldc = 512; coff = (hb - 9) * 128; }
            else if (hb < 21) { dst = acat; ldc = 1024; coff = (hb - 13) * 128; act = 1; }
            else if (hb < 29) { dst = sma; ldc = 1024; coff = (hb - 21) * 128; act = 2; }
            else if (hb < 37) { dst = smb; ldc = 1024; coff = (hb - 29) * 128; act = 2; }
            else { dst = small; ldc = 128; coff = 0; act = (wc == 0) ? 3 : 0; }
            const bool dosq = hb < 5;
#pragma unroll
            for (int ai = 0; ai < 2; ++ai)
#pragma unroll
                for (int m = 0; m < 4; ++m) {
                    const int row = u.pm * BM + ai * HALF + wr * 64 + m * 16 + fr;
                    f32x4 v0 = acc[ai][bj][m][0], v1 = acc[ai][bj][m][1];
                    if (dosq) { const float s = red_fq(sum8sq(v0, v1)); if (fq == 0) ssqa[(size_t)row * 32 + hb * 4 + wc] = s; }
                    if (act == 1) {
#pragma unroll
                        for (int e = 0; e < 4; ++e) { v0[e] = v0[e] * sigm(v0[e]); v1[e] = v1[e] * sigm(v1[e]); }
                    } else if (act == 2) {
#pragma unroll
                        for (int e = 0; e < 4; ++e) { v0[e] = sigm(v0[e]); v1[e] = sigm(v1[e]); }
                    } else if (act == 3) {
                        const f32x4* rp = (const f32x4*)(rope + (size_t)row * 32 + 8 * fq); const f32x4 r0 = rp[0], r1 = rp[1];
                        const float c[4] = {r0[0], r0[2], r1[0], r1[2]}, s[4] = {r0[1], r0[3], r1[1], r1[3]};
#pragma unroll
                        for (int e = 0; e < 4; ++e) { const float x1 = v0[e], x2 = v1[e]; v0[e] = x1 * c[e] - x2 * s[e]; v1[e] = x2 * c[e] + x1 * s[e]; }
                    }
                    *(u32x4*)(dst + (size_t)row * ldc + coff + wc * 32 + 8 * fq) = pack8(v0, v1);
                }
        }
    }
};

struct EpiQ {
    static constexpr bool PERM = true, HAS_MID = false;
    bf16_t* q; const float* ssqa; const float* rope;
    __device__ __forceinline__ void mid(Acc&, const Unit&, int, int, int, int) const {}
    __device__ __forceinline__ void operator()(const Acc& acc, const Unit& u, int wr, int wc, int fr, int fq) const {
#pragma unroll
        for (int ai = 0; ai < 2; ++ai)
#pragma unroll
            for (int m = 0; m < 4; ++m) {
                const int row = u.pm * BM + ai * HALF + wr * 64 + m * 16 + fr;
                const f32x4* sp = (const f32x4*)(ssqa + (size_t)row * 32); const f32x4 a = sp[0], b = sp[1], c = sp[2];
                const float tot = ((a[0] + a[1]) + (a[2] + a[3])) + ((b[0] + b[1]) + (b[2] + b[3])) + ((c[0] + c[1]) + (c[2] + c[3]));
                const float rs = rsq(tot * (1.f / 384.f) + EPS) * C2Q;
#pragma unroll
                for (int bj = 0; bj < 2; ++bj) {
                    const int grp = 8 * u.pn + 4 * bj + wc;
                    f32x4 v0 = acc[ai][bj][m][0] * rs, v1 = acc[ai][bj][m][1] * rs;
                    if ((grp % 3) == 2) {
                        const f32x4* rp = (const f32x4*)(rope + (size_t)row * 32 + 8 * fq); const f32x4 r0 = rp[0], r1 = rp[1];
                        const float cc[4] = {r0[0], r0[2], r1[0], r1[2]}, ss[4] = {r0[1], r0[3], r1[1], r1[3]};
#pragma unroll
                        for (int e = 0; e < 4; ++e) { const float x1 = v0[e], x2 = v1[e]; v0[e] = x1 * cc[e] - x2 * ss[e]; v1[e] = x2 * cc[e] + x1 * ss[e]; }
                    }
                    *(u32x4*)(q + (size_t)row * 768 + u.pn * BM + bj * HALF + wc * 32 + 8 * fq) = pack8(v0, v1);
                }
            }
    }
};
struct EpiKV {
    static constexpr bool PERM = true, HAS_MID = false;
    bf16_t* kv; const float* ssqa;
    __device__ __forceinline__ void mid(Acc&, const Unit&, int, int, int, int) const {}
    __device__ __forceinline__ void operator()(const Acc& acc, const Unit& u, int wr, int wc, int fr, int fq) const {
#pragma unroll
        for (int ai = 0; ai < 2; ++ai)
#pragma unroll
            for (int m = 0; m < 4; ++m) {
                const int row = u.pm * BM + ai * HALF + wr * 64 + m * 16 + fr;
                const f32x4* sp = (const f32x4*)(ssqa + (size_t)row * 32 + 12); const f32x4 a = sp[0], b = sp[1];
                const float tot = ((a[0] + a[1]) + (a[2] + a[3])) + ((b[0] + b[1]) + (b[2] + b[3]));
                const float rs = rsq(tot * (1.f / 256.f) + EPS);
#pragma unroll
                for (int bj = 0; bj < 2; ++bj) {
                    const f32x4 v0 = acc[ai][bj][m][0] * rs, v1 = acc[ai][bj][m][1] * rs;
                    *(u32x4*)(kv + (size_t)row * 1024 + u.pn * BM + bj * HALF + wc * 32 + 8 * fq) = pack8(v0, v1);
                }
            }
    }
};
struct EpiMerge {
    static constexpr bool PERM = true, HAS_MID = true;
    const bf16_t* sma; const bf16_t* smb; bf16_t* out;
    __device__ __forceinline__ void mid(Acc& acc, const Unit& u, int wr, int wc, int fr, int fq) const {
#pragma unroll
        for (int ai = 0; ai < 2; ++ai)
#pragma unroll
            for (int m = 0; m < 4; ++m) {
                const int row = u.pm * BM + ai * HALF + wr * 64 + m * 16 + fr;
#pragma unroll
                for (int bj = 0; bj < 2; ++bj) {
                    const size_t off = (size_t)row * 1024 + u.pn * BM + bj * HALF + wc * 32 + 8 * fq;
                    const u32x4 a = *(const u32x4*)(sma + off), b = *(const u32x4*)(smb + off);
#pragma unroll
                    for (int e = 0; e < 4; ++e) {
                        const unsigned aw = a[e], bw = b[e];
                        const float r0 = bflo(aw) * __builtin_amdgcn_rcpf(bflo(bw)), r1 = bfhi(aw) * __builtin_amdgcn_rcpf(bfhi(bw));
                        acc[ai][bj][m][e >> 1][(e & 1) * 2] *= r0; acc[ai][bj][m][e >> 1][(e & 1) * 2 + 1] *= r1;
                    }
                }
                asm volatile("" ::: "memory");
            }
    }
    __device__ __forceinline__ void operator()(const Acc& acc, const Unit& u, int wr, int wc, int fr, int fq) const {
#pragma unroll
        for (int ai = 0; ai < 2; ++ai)
#pragma unroll
            for (int m = 0; m < 4; ++m) {
                const int row = u.pm * BM + ai * HALF + wr * 64 + m * 16 + fr;
#pragma unroll
                for (int bj = 0; bj < 2; ++bj) {
                    const size_t off = (size_t)row * 1024 + u.pn * BM + bj * HALF + wc * 32 + 8 * fq;
                    const u32x4 b = *(const u32x4*)(smb + off);
                    f32x4 v0 = acc[ai][bj][m][0], v1 = acc[ai][bj][m][1];
                    v0[0] *= bflo(b[0]); v0[1] *= bfhi(b[0]); v0[2] *= bflo(b[1]); v0[3] *= bfhi(b[1]);
                    v1[0] *= bflo(b[2]); v1[1] *= bfhi(b[2]); v1[2] *= bflo(b[3]); v1[3] *= bfhi(b[3]);
                    *(u32x4*)(out + off) = pack8(v0, v1);
                }
            }
    }
};
struct EpiX1 {
    static constexpr bool PERM = true, HAS_MID = false;
    const float* x; float* x1; bf16_t* x1b; float* ssq1;
    __device__ __forceinline__ void mid(Acc&, const Unit&, int, int, int, int) const {}
    __device__ __forceinline__ void operator()(const Acc& acc, const Unit& u, int wr, int wc, int fr, int fq) const {
#pragma unroll
        for (int ai = 0; ai < 2; ++ai)
#pragma unroll
            for (int m = 0; m < 4; ++m) {
                const int row = u.pm * BM + ai * HALF + wr * 64 + m * 16 + fr; float sq = 0.f;
#pragma unroll
                for (int bj = 0; bj < 2; ++bj) {
                    const size_t off = (size_t)row * 1024 + u.pn * BM + bj * HALF + wc * 32 + 8 * fq;
                    const f32x4 xa = *(const f32x4*)(x + off), xb = *(const f32x4*)(x + off + 4);
                    const f32x4 v0 = acc[ai][bj][m][0] + xa, v1 = acc[ai][bj][m][1] + xb;
                    *(f32x4*)(x1 + off) = v0; *(f32x4*)(x1 + off + 4) = v1;
                    sq += sum8sq(v0, v1);
                    *(u32x4*)(x1b + off) = pack8(v0, v1);
                }
                sq = red_fq(sq); if (fq == 0) ssq1[(size_t)row * 16 + u.pn * 4 + wc] = sq;
            }
    }
};
struct EpiE {
    static constexpr bool PERM = true, HAS_MID = false;
    bf16_t* e; float* ssqe;
    __device__ __forceinline__ void mid(Acc&, const Unit&, int, int, int, int) const {}
    __device__ __forceinline__ void operator()(const Acc& acc, const Unit& u, int wr, int wc, int fr, int fq) const {
#pragma unroll
        for (int ai = 0; ai < 2; ++ai)
#pragma unroll
            for (int m = 0; m < 4; ++m) {
                const int row = u.pm * BM + ai * HALF + wr * 64 + m * 16 + fr; float sq = 0.f;
#pragma unroll
                for (int bj = 0; bj < 2; ++bj) {
                    const size_t off = (size_t)row * 1024 + u.pn * BM + bj * HALF + wc * 32 + 8 * fq;
                    const f32x4 v0 = acc[ai][bj][m][0], v1 = acc[ai][bj][m][1];
                    sq += sum8sq(v0, v1);
                    *(u32x4*)(e + off) = pack8(v0, v1);
                }
                sq = red_fq(sq); if (fq == 0) ssqe[(size_t)row * 16 + u.pn * 4 + wc] = sq;
            }
    }
};
struct EpiG {
    static constexpr bool PERM = true, HAS_MID = false;
    const float* ssq1; const float* ssqe; const bf16_t* e; const float* gple; float* xio; float* ssq2;
    __device__ __forceinline__ void mid(Acc&, const Unit&, int, int, int, int) const {}
    __device__ __forceinline__ float row16(const float* p) const {
        const f32x4* sp = (const f32x4*)p; const f32x4 a = sp[0], b = sp[1], c = sp[2], d = sp[3];
        return (((a[0] + a[1]) + (a[2] + a[3])) + ((b[0] + b[1]) + (b[2] + b[3]))) + (((c[0] + c[1]) + (c[2] + c[3])) + ((d[0] + d[1]) + (d[2] + d[3])));
    }
    __device__ __forceinline__ void operator()(const Acc& acc, const Unit& u, int wr, int wc, int fr, int fq) const {
#pragma unroll
        for (int ai = 0; ai < 2; ++ai)
#pragma unroll
            for (int m = 0; m < 4; ++m) {
                const int row = u.pm * BM + ai * HALF + wr * 64 + m * 16 + fr; float sq = 0.f;
                const float rs1 = rsq(row16(ssq1 + (size_t)row * 16) * (1.f / 1024.f) + EPS), rse = rsq(row16(ssqe + (size_t)row * 16) * (1.f / 1024.f) + EPS);
#pragma unroll
                for (int bj = 0; bj < 2; ++bj) {
                    const int col = u.pn * BM + bj * HALF + wc * 32 + 8 * fq; const size_t off = (size_t)row * 1024 + col;
                    const f32x4 xa = *(const f32x4*)(xio + off), xb = *(const f32x4*)(xio + off + 4);
                    const f32x4 ga = *(const f32x4*)(gple + col), gb = *(const f32x4*)(gple + col + 4);
                    const u32x4 ew = *(const u32x4*)(e + off);
                    const float ev[8] = {bflo(ew[0]), bfhi(ew[0]), bflo(ew[1]), bfhi(ew[1]), bflo(ew[2]), bfhi(ew[2]), bflo(ew[3]), bfhi(ew[3])};
                    f32x4 v0, v1;
#pragma unroll
                    for (int k = 0; k < 4; ++k) {
                        v0[k] = xa[k] + sigm(acc[ai][bj][m][0][k] * rs1) * (ev[k] * rse * ga[k]);
                        v1[k] = xb[k] + sigm(acc[ai][bj][m][1][k] * rs1) * (ev[4 + k] * rse * gb[k]);
                    }
                    *(f32x4*)(xio + off) = v0; *(f32x4*)(xio + off + 4) = v1;
                    sq += sum8sq(v0, v1);
                }
                sq = red_fq(sq); if (fq == 0) ssq2[(size_t)row * 16 + u.pn * 4 + wc] = sq;
            }
    }
};

template <class Epi, class Sched, bool ALIGN_EPI = false, bool SP2 = false>
__device__ __forceinline__ void gemm_phase(LAS unsigned char* lds, const Gemm g, const Sched& S, const Epi& E) {
    int tid_ = threadIdx.x; asm volatile("" : "+v"(tid_));
    const int tid = tid_, wid = __builtin_amdgcn_readfirstlane(tid >> 6), lane = tid & 63, wr = wid >> 2, wc = wid & 3, fr = lane & 15, fq = lane >> 4;
    const int K = g.K, nt = K / BK, lda = g.lda;
    unsigned voffA[2], voffB[2];
#pragma unroll
    for (int i = 0; i < 2; ++i) { int R, C; stage_rc(tid * 16 + i * 8192, R, C); const int Rb = Epi::PERM ? ((R & ~31) + perm32(R & 31)) : R;
        voffA[i] = (unsigned)(R * lda + C) * 2u; voffB[i] = (unsigned)(Rb * K + C) * 2u; }
    const size_t kstep = (size_t)(BK * 2);
    const size_t hstepA = (size_t)HALF * lda * 2, hstepB = (size_t)HALF * K * 2;
    const size_t tstepA = 2 * hstepA, tstepB = 2 * hstepB;
    const unsigned ldsw = (unsigned)wid * 1024u;
    const int aoff = lds_byte(wr * 64 + fr, fq * 8), boff = lds_byte(wc * 32 + fr, fq * 8);
#define PG8_SA(b, h) (((b) * 2 + (h)) * HTB)
#define PG8_SB(b, h) ((4 + (b) * 2 + (h)) * HTB)
#define PG8_STAGE(bufoff, gbase, voff) do { _Pragma("unroll") for (int _i = 0; _i < 2; ++_i) \
        __builtin_amdgcn_global_load_lds((const unsigned*)((const char*)(gbase) + (voff)[_i]), (LAS unsigned*)(lds + (bufoff) + ldsw + _i * 8192), 16, 0, 0); } while (0)
#define PG8_LDA(dst, b, h) do { _Pragma("unroll") for (int m = 0; m < 4; ++m) _Pragma("unroll") for (int k = 0; k < 2; ++k) dst[m][k] = *(const LAS bf16x8*)(lds + PG8_SA(b, h) + aoff + m * 2048 + k * 1024); } while (0)
#define PG8_LDB(dst, b, h) do { _Pragma("unroll") for (int n = 0; n < 2; ++n) _Pragma("unroll") for (int k = 0; k < 2; ++k) dst[n][k] = *(const LAS bf16x8*)(lds + PG8_SB(b, h) + boff + n * 2048 + k * 1024); } while (0)
#define PG8_MMA(ai, bj, At, Bt) do { __builtin_amdgcn_s_setprio(1); _Pragma("unroll") for (int m = 0; m < 4; ++m) _Pragma("unroll") for (int n = 0; n < 2; ++n) _Pragma("unroll") for (int k = 0; k < 2; ++k) \
        acc[ai][bj][m][n] = __builtin_amdgcn_mfma_f32_16x16x32_bf16(Bt[n][k], At[m][k], acc[ai][bj][m][n], 0, 0, 0); __builtin_amdgcn_s_setprio(0); } while (0)
#define PG8_WAIT_V(n) asm volatile("s_waitcnt vmcnt(" #n ")" ::: "memory")
#define PG8_WAIT_L(n) asm volatile("s_waitcnt lgkmcnt(" #n ")" ::: "memory")
#define PG8_BAR __builtin_amdgcn_s_barrier()
#define PG8_SCHED __builtin_amdgcn_sched_barrier(0)
    Unit cur, nxt; int ui = 0;
    if (!S.next(0, cur)) return;
    Acc acc;
#pragma unroll
    for (int a = 0; a < 2; ++a)
#pragma unroll
        for (int b = 0; b < 2; ++b)
#pragma unroll
            for (int m = 0; m < 4; ++m)
#pragma unroll
                for (int n = 0; n < 2; ++n) acc[a][b][m][n] = (f32x4){0.f, 0.f, 0.f, 0.f};
    bf16x8 At[4][2], B0[2][2], B1[2][2];
    const char* cA = (const char*)g.A + (size_t)cur.pm * tstepA; const char* cB = (const char*)g.Bt + (size_t)cur.pn * tstepB;
    if constexpr (SP2) {
        PG8_STAGE(PG8_SB(0, 0), cB, voffB); PG8_STAGE(PG8_SB(0, 1), cB + hstepB, voffB); PG8_STAGE(PG8_SA(0, 0), cA, voffA); PG8_STAGE(PG8_SA(0, 1), cA + hstepA, voffA);
        if (wr == 1) PG8_BAR;
        PG8_WAIT_V(2); PG8_BAR;
        PG8_STAGE(PG8_SB(1, 0), cB + kstep, voffB); PG8_STAGE(PG8_SA(1, 0), cA + kstep, voffA); PG8_STAGE(PG8_SB(1, 1), cB + hstepB + kstep, voffB);
        PG8_WAIT_V(6); PG8_BAR;
    } else {
        PG8_STAGE(PG8_SB(0, 0), cB, voffB); PG8_STAGE(PG8_SA(0, 0), cA, voffA); PG8_STAGE(PG8_SB(0, 1), cB + hstepB, voffB); PG8_STAGE(PG8_SA(0, 1), cA + hstepA, voffA);
        if (wr == 1) PG8_BAR;
        PG8_WAIT_V(4); PG8_BAR;
        PG8_STAGE(PG8_SB(1, 0), cB + kstep, voffB); PG8_STAGE(PG8_SA(1, 0), cA + kstep, voffA); PG8_STAGE(PG8_SB(1, 1), cB + hstepB + kstep, voffB);
        PG8_WAIT_V(6); PG8_BAR;
    }
    for (;;) {
        const bool has_next = S.next(ui + 1, nxt);
        const char* nA = has_next ? (const char*)g.A + (size_t)nxt.pm * tstepA : cA; const char* nB = has_next ? (const char*)g.Bt + (size_t)nxt.pn * tstepB : cB;
        auto kloop = [&](const int t0, const int t1) __attribute__((always_inline)) {
        for (int t = t0; t < t1; t += 2) {
            const bool last = (t == nt - 2);
            const char* a1 = cA + (size_t)(t + 1) * kstep;
            const char* a2 = last ? nA : cA + (size_t)(t + 2) * kstep; const char* b2 = last ? nB : cB + (size_t)(t + 2) * kstep;
            const char* a3 = a2 + kstep; const char* b3 = b2 + kstep;
            if constexpr (SP2) {
            PG8_LDB(B0, 0, 0); PG8_LDB(B1, 0, 1); PG8_SCHED; PG8_LDA(At, 0, 0); PG8_STAGE(PG8_SA(1, 1), a1 + hstepA, voffA);
            PG8_WAIT_V(8); PG8_WAIT_L(0); PG8_BAR; PG8_MMA(0, 0, At, B0); PG8_MMA(0, 1, At, B1); PG8_BAR; PG8_SCHED;
            PG8_LDA(At, 0, 1); PG8_STAGE(PG8_SB(0, 0), b2, voffB); PG8_STAGE(PG8_SB(0, 1), b2 + hstepB, voffB); PG8_STAGE(PG8_SA(0, 0), a2, voffA);
            PG8_WAIT_V(8); PG8_WAIT_L(0); PG8_BAR; PG8_MMA(1, 0, At, B0); PG8_MMA(1, 1, At, B1); PG8_BAR; PG8_SCHED;
            PG8_LDB(B0, 1, 0); PG8_LDB(B1, 1, 1); PG8_SCHED; PG8_LDA(At, 1, 0); PG8_STAGE(PG8_SA(0, 1), a2 + hstepA, voffA);
            PG8_WAIT_V(8); PG8_WAIT_L(0); PG8_BAR; PG8_MMA(0, 0, At, B0); PG8_MMA(0, 1, At, B1); PG8_BAR; PG8_SCHED;
            PG8_LDA(At, 1, 1); PG8_STAGE(PG8_SB(1, 0), b3, voffB); PG8_STAGE(PG8_SB(1, 1), b3 + hstepB, voffB); PG8_STAGE(PG8_SA(1, 0), a3, voffA);
            PG8_WAIT_V(8); PG8_WAIT_L(0); PG8_BAR; PG8_MMA(1, 0, At, B0); PG8_MMA(1, 1, At, B1); PG8_BAR; PG8_SCHED;
            } else {
            PG8_LDB(B0, 0, 0); PG8_SCHED; PG8_LDA(At, 0, 0); PG8_STAGE(PG8_SA(1, 1), a1 + hstepA, voffA);
            PG8_WAIT_L(8); PG8_BAR; PG8_WAIT_L(0); PG8_MMA(0, 0, At, B0); PG8_BAR; PG8_SCHED;
            PG8_LDB(B1, 0, 1); PG8_STAGE(PG8_SB(0, 0), b2, voffB);
            PG8_BAR; PG8_WAIT_L(0); PG8_MMA(0, 1, At, B1); PG8_BAR;
            PG8_LDA(At, 0, 1); PG8_STAGE(PG8_SA(0, 0), a2, voffA);
            PG8_BAR; PG8_WAIT_L(0); PG8_MMA(1, 0, At, B0); PG8_BAR; PG8_SCHED;
            PG8_STAGE(PG8_SB(0, 1), b2 + hstepB, voffB);
            PG8_WAIT_V(6); PG8_BAR; PG8_MMA(1, 1, At, B1); PG8_BAR;
            PG8_LDB(B0, 1, 0); PG8_SCHED; PG8_LDA(At, 1, 0); PG8_STAGE(PG8_SA(0, 1), a2 + hstepA, voffA);
            PG8_WAIT_L(8); PG8_BAR; PG8_WAIT_L(0); PG8_MMA(0, 0, At, B0); PG8_BAR; PG8_SCHED;
            PG8_LDB(B1, 1, 1); PG8_STAGE(PG8_SB(1, 0), b3, voffB);
            PG8_BAR; PG8_WAIT_L(0); PG8_MMA(0, 1, At, B1); PG8_BAR;
            PG8_LDA(At, 1, 1); PG8_STAGE(PG8_SA(1, 0), a3, voffA);
            PG8_BAR; PG8_WAIT_L(0); PG8_MMA(1, 0, At, B0); PG8_BAR; PG8_SCHED;
            PG8_STAGE(PG8_SB(1, 1), b3 + hstepB, voffB);
            PG8_WAIT_V(6); PG8_BAR; PG8_MMA(1, 1, At, B1); PG8_BAR;
            }
        }
        };
        if constexpr (Epi::HAS_MID) { kloop(0, nt >> 1); E.mid(acc, cur, wr, wc, fr, fq); kloop(nt >> 1, nt); }
        else kloop(0, nt);
        if constexpr (ALIGN_EPI) { if (wr == 0) PG8_BAR; }
        E(acc, cur, wr, wc, fr, fq);
        if (!has_next) break;
#pragma unroll
        for (int a = 0; a < 2; ++a)
#pragma unroll
            for (int b = 0; b < 2; ++b)
#pragma unroll
                for (int m = 0; m < 4; ++m)
#pragma unroll
                    for (int n = 0; n < 2; ++n) acc[a][b][m][n] = (f32x4){0.f, 0.f, 0.f, 0.f};
        cur = nxt; cA = nA; cB = nB; ++ui;
        if constexpr (ALIGN_EPI) { if (wr == 1) PG8_BAR; }
    }
    PG8_WAIT_V(0);
    if constexpr (!ALIGN_EPI) { if (wr == 0) PG8_BAR; }
    PG8_BAR;
#undef PG8_SA
#undef PG8_SB
#undef PG8_STAGE
#undef PG8_LDA
#undef PG8_LDB
#undef PG8_MMA
#undef PG8_WAIT_V
#undef PG8_WAIT_L
#undef PG8_BAR
#undef PG8_SCHED
}
}

namespace att {
constexpr int KSL = 12288, VSL = 8192;
constexpr int L_K = 0, L_V = 2 * KSL, L_WS = L_V + 2 * VSL, L_OST = L_WS + 8 * 256, L_END = L_OST + 8 * 4096;
constexpr float THR = 8.f;
__device__ __forceinline__ int crow(int r, int hi) { return (r & 3) + 8 * (r >> 2) + 4 * hi; }
typedef short v4i16_t __attribute__((ext_vector_type(4)));
__device__ __forceinline__ s16x4 vtr(const LAS unsigned char* p) { return __builtin_bit_cast(s16x4, __builtin_amdgcn_ds_read_tr16_b64_v4i16((LAS v4i16_t*)p)); }
#define MX3(a, b, c) __builtin_fmaxf(__builtin_fmaxf((a), (b)), (c))
__device__ __forceinline__ float rowmax(const f32x16& p0, const f32x16& p1) {
    float a = MX3(p0[0], p0[1], p1[0]), b = MX3(p0[2], p0[3], p1[1]); a = MX3(a, p1[2], p1[3]);
#pragma unroll
    for (int r = 4; r < 16; r += 4) { a = MX3(a, p0[r], p0[r + 1]); b = MX3(b, p0[r + 2], p0[r + 3]); a = MX3(a, p1[r], p1[r + 1]); b = MX3(b, p1[r + 2], p1[r + 3]); }
    float m = __builtin_fmaxf(a, b); auto rr = __builtin_amdgcn_permlane32_swap(__float_as_uint(m), __float_as_uint(m), false, false);
    return __builtin_fmaxf(__uint_as_float(rr[0]), __uint_as_float(rr[1]));
}
#undef MX3
__device__ __forceinline__ void cmask(f32x16& p0, f32x16& p1, int jb, int qrel, int hi) {
    const int kb = 64 * jb + 4 * hi;
#pragma unroll
    for (int r = 0; r < 16; ++r) { const int kv = kb + (r & 3) + 8 * (r >> 2); if (kv > qrel) p0[r] = -INFINITY; if (kv + 32 > qrel) p1[r] = -INFINITY; }
}
__device__ __forceinline__ void glds(const void* g, LAS unsigned char* l) { __builtin_amdgcn_global_load_lds((const unsigned*)g, (LAS unsigned*)l, 16, 0, 0); }

__device__ __forceinline__ void attn_unit(int b, int h, int qb, const bf16_t* Q, const bf16_t* KV, const bf16_t* KR, bf16_t* ACAT, LAS unsigned char* lds) {
    const int tid = threadIdx.x, lane = tid & 63, r32 = lane & 31, hi = lane >> 5; const int wid = __builtin_amdgcn_readfirstlane(tid >> 6);
    const size_t rowbase = (size_t)b * SEQ; const int q0 = qb * 256, NT = 4 * qb + 4;
    const bf16_t* Qw = Q + (rowbase + q0 + wid * 32 + r32) * 768 + h * 96 + hi * 8;
    bf16x8 qr[6];
#pragma unroll
    for (int d0 = 0; d0 < 6; ++d0) qr[d0] = *(const bf16x8*)(Qw + d0 * 16);
    const bf16_t* ksrc = KV + (rowbase + lane) * 1024 + h * 128 + wid * 8;
    const bf16_t* rsrc = KR + (rowbase + lane) * 128 + (wid & 3) * 8;
    const bf16_t* vsrc = KV + (rowbase + 16 * (wid & 3) + (lane >> 2)) * 1024 + h * 128 + 64 + (wid >> 2) * 32 + (lane & 3) * 8;
#define ATT_DMA(t, buf) do { glds(ksrc + (size_t)(t) * 64 * 1024, lds + L_K + (buf) * KSL + wid * 1024); \
        if (wid < 4) glds(rsrc + (size_t)(t) * 64 * 128, lds + L_K + (buf) * KSL + (8 + wid) * 1024); \
        glds(vsrc + (size_t)(t) * 64 * 1024, lds + L_V + (buf) * VSL + wid * 1024); } while (0)
    LAS float* wsf = (LAS float*)(lds + L_WS) + wid * 64;
    const int qrel = wid * 32 + r32;
    float mhat = 0.f, l_reg = 0.f; f32x16 o0 = {}, o1 = {};
    ATT_DMA(0, 0);
    for (int t = 0; t < NT; ++t) {
        asm volatile("s_waitcnt vmcnt(0)" ::: "memory");
        __syncthreads();
        if (t + 1 < NT) ATT_DMA(t + 1, (t + 1) & 1);
        const int buf = t & 1;
        const LAS unsigned char* kp = lds + L_K + buf * KSL + hi * 1024 + r32 * 16;
        f32x16 p0 = {}, p1 = {};
#pragma unroll
        for (int d0 = 0; d0 < 6; ++d0) {
            const bf16x8 b0 = *(const LAS bf16x8*)(kp + d0 * 2048), b1 = *(const LAS bf16x8*)(kp + d0 * 2048 + 512);
            p0 = __builtin_amdgcn_mfma_f32_32x32x16_bf16(b0, qr[d0], p0, 0, 0, 0);
            p1 = __builtin_amdgcn_mfma_f32_32x32x16_bf16(b1, qr[d0], p1, 0, 0, 0);
        }
        if (t >= NT - 4) cmask(p0, p1, t - (NT - 4), qrel, hi);
        const float rm = rowmax(p0, p1);
        if (t == 0) mhat = rm;
        else if (__any(rm > mhat + THR)) {
            const float mn = __builtin_fmaxf(mhat, rm), f = __builtin_amdgcn_exp2f(mhat - mn);
            l_reg *= f; mhat = mn;
            if (hi == 0) wsf[r32] = f;
            asm volatile("s_waitcnt lgkmcnt(0)" ::: "memory");
#pragma unroll
            for (int r = 0; r < 16; ++r) { const float fr_ = wsf[crow(r, hi)]; o0[r] *= fr_; o1[r] *= fr_; }
        }
        float sacc = 0.f;
#pragma unroll
        for (int r = 0; r < 16; ++r) { p0[r] = __builtin_amdgcn_exp2f(p0[r] - mhat); p1[r] = __builtin_amdgcn_exp2f(p1[r] - mhat); sacc += p0[r] + p1[r]; }
        l_reg += sacc;
        u32x4 pw[4];
#pragma unroll
        for (int j = 0; j < 4; ++j) { pw[0][j] = cvt_pk_bf16(p0[2 * j], p0[2 * j + 1]); pw[1][j] = cvt_pk_bf16(p0[8 + 2 * j], p0[8 + 2 * j + 1]);
                                      pw[2][j] = cvt_pk_bf16(p1[2 * j], p1[2 * j + 1]); pw[3][j] = cvt_pk_bf16(p1[8 + 2 * j], p1[8 + 2 * j + 1]); }
        const LAS unsigned char* vp = lds + L_V + buf * VSL + ((lane >> 4) & 1) * 32 + (lane & 3) * 8 + (4 * hi + ((lane & 15) >> 2)) * 64;
#pragma unroll
        for (int ks = 0; ks < 4; ++ks) {
            const s16x4 lo0 = vtr(vp + ks * 1024), hi0 = vtr(vp + ks * 1024 + 512), lo1 = vtr(vp + 4096 + ks * 1024), hi1 = vtr(vp + 4096 + ks * 1024 + 512);
            const bf16x8 v0 = (bf16x8){lo0[0], lo0[1], lo0[2], lo0[3], hi0[0], hi0[1], hi0[2], hi0[3]}, v1 = (bf16x8){lo1[0], lo1[1], lo1[2], lo1[3], hi1[0], hi1[1], hi1[2], hi1[3]};
            const bf16x8 pa = __builtin_bit_cast(bf16x8, pw[ks]);
            o0 = __builtin_amdgcn_mfma_f32_32x32x16_bf16(pa, v0, o0, 0, 0, 0);
            o1 = __builtin_amdgcn_mfma_f32_32x32x16_bf16(pa, v1, o1, 0, 0, 0);
        }
    }
#undef ATT_DMA
    { auto rr = __builtin_amdgcn_permlane32_swap(__float_as_uint(l_reg), __float_as_uint(l_reg), false, false); l_reg = __uint_as_float(rr[0]) + __uint_as_float(rr[1]); }
    if (hi == 0) wsf[32 + r32] = l_reg;
    asm volatile("s_waitcnt lgkmcnt(0)" ::: "memory");
    LAS bf16_t* stg = (LAS bf16_t*)(lds + L_OST) + wid * 2048;
#pragma unroll
    for (int r = 0; r < 16; ++r) { const int orow = crow(r, hi); const float rl = __builtin_amdgcn_rcpf(wsf[32 + orow]);
        stg[orow * 64 + r32] = (bf16_t)(cvt_pk_bf16(o0[r] * rl, 0.f) & 0xffffu); stg[orow * 64 + 32 + r32] = (bf16_t)(cvt_pk_bf16(o1[r] * rl, 0.f) & 0xffffu); }
    asm volatile("s_waitcnt lgkmcnt(0)" ::: "memory");
    bf16_t* Ow = ACAT + (rowbase + q0 + wid * 32) * 1024 + h * 64;
#pragma unroll
    for (int i = 0; i < 4; ++i) { const int row = i * 8 + (lane >> 3), ch = lane & 7;
        const u32x4 v = *(const LAS u32x4*)(stg + row * 64 + ch * 8); bf16_t* gp = Ow + (size_t)row * 1024 + ch * 8; const u32x4 gt = *(const u32x4*)gp; u32x4 w;
#pragma unroll
        for (int e = 0; e < 4; ++e) w[e] = cvt_pk_bf16(bflo(v[e]) * bflo(gt[e]), bfhi(v[e]) * bfhi(gt[e]));
        *(u32x4*)gp = w; }
    asm volatile("s_waitcnt lgkmcnt(0)" ::: "memory");
    __syncthreads();
}
}

namespace gla {
constexpr int P = 144;
constexpr int L_QD = 0, L_KD = 9216, L_KDT = 18432, L_VT = 27648, L_ATT = 46080, L_TOT = 55296, L_EB = 57344, L_SSQ = 57600, L_GKL = 59648, L_END = 63744;
__device__ __forceinline__ f32x4 mfma16(bf16x8 a, bf16x8 b, f32x4 c) { return __builtin_amdgcn_mfma_f32_16x16x32_bf16(a, b, c, 0, 0, 0); }
__device__ __forceinline__ float logsig(float x) { return __builtin_fminf(x, 0.f) - __logf(1.f + __expf(-__builtin_fabsf(x))); }

__device__ __forceinline__ void gla_item(int bh, const bf16_t* GQ, const bf16_t* GK, const bf16_t* GV, const bf16_t* SMALL, const float* w_up, const float* b_gk, const float* gnorm, bf16_t* ACAT, LAS unsigned char* lds) {
    const int tid = threadIdx.x, lane = tid & 63, l15 = lane & 15, kg = lane >> 4; const int w = __builtin_amdgcn_readfirstlane(tid >> 6);
    const int b = bh >> 2, h = bh & 3;
    float wup[16];
#pragma unroll
    for (int r = 0; r < 16; ++r) wup[r] = w_up[r * 256 + h * 64 + lane];
    const float bias = b_gk[h * 64 + lane], gn = gnorm[16 * w + l15];
    LAS float* TOT = (LAS float*)(lds + L_TOT); LAS float* EB = (LAS float*)(lds + L_EB); LAS float* SSQ = (LAS float*)(lds + L_SSQ); LAS float* GKL = (LAS float*)(lds + L_GKL);
    f32x4 S[4];
#pragma unroll
    for (int i = 0; i < 4; ++i) S[i] = (f32x4){0.f, 0.f, 0.f, 0.f};
    const int vc = tid & 127, tg2 = tid >> 7;
    for (int n = 0; n < 32; ++n) {
        const size_t row0 = (size_t)b * SEQ + (size_t)n * 64;
        { const int tok = tid >> 3, pr = tid & 7; const unsigned g2 = *(const unsigned*)(SMALL + (row0 + tok) * 128 + 32 + 2 * pr); GKL[tok * 16 + 2 * pr] = bflo(g2); GKL[tok * 16 + 2 * pr + 1] = bfhi(g2); }
        bf16_t qv[8], kv[8], vv[16];
        { const GAS bf16_t* qp = (const GAS bf16_t*)(GQ + (row0 + 8 * w) * 256 + h * 64 + lane); const GAS bf16_t* kp = (const GAS bf16_t*)(GK + (row0 + 8 * w) * 256 + h * 64 + lane); const GAS bf16_t* vp = (const GAS bf16_t*)(GV + (row0 + 16 * tg2) * 512 + h * 128 + vc);
          asm volatile("" : "+v"(qp), "+v"(kp), "+v"(vp));
#pragma unroll
          for (int e = 0; e < 8; ++e) { qv[e] = qp[e * 256]; kv[e] = kp[e * 256]; }
#pragma unroll
          for (int e = 0; e < 16; ++e) vv[e] = vp[e * 512]; }
        __syncthreads();
        float c8[8]; float run = 0.f;
#pragma unroll
        for (int e = 0; e < 8; ++e) {
            const LAS f32x4* gp = (const LAS f32x4*)(GKL + (8 * w + e) * 16); float x = bias;
#pragma unroll
            for (int r4 = 0; r4 < 4; ++r4) { const f32x4 gq4 = gp[r4]; x += gq4[0] * wup[4 * r4] + gq4[1] * wup[4 * r4 + 1] + gq4[2] * wup[4 * r4 + 2] + gq4[3] * wup[4 * r4 + 3]; }
            run += logsig(x) * (1.f / 16.f); c8[e] = run;
        }
        TOT[w * 64 + lane] = run;
        __syncthreads();
        float prefix = 0.f, total = 0.f;
#pragma unroll
        for (int ww = 0; ww < 8; ++ww) { const float tv = TOT[ww * 64 + lane]; total += tv; if (ww < w) prefix += tv; }
        {
            float kd8[8];
#pragma unroll
            for (int e = 0; e < 8; ++e) {
                const float bc = prefix + c8[e], eq = __expf(bc), ek = __expf(-bc), ed = __expf(total - bc);
                const float qf = bf1(qv[e]) * 0.125f * eq, kf = bf1(kv[e]);
                *(LAS bf16_t*)(lds + L_QD + (8 * w + e) * P + lane * 2) = (bf16_t)(cvt_pk_bf16(qf, 0.f) & 0xffffu);
                *(LAS bf16_t*)(lds + L_KD + (8 * w + e) * P + lane * 2) = (bf16_t)(cvt_pk_bf16(kf * ek, 0.f) & 0xffffu);
                kd8[e] = kf * ed;
            }
            u32x4 kw; kw.x = cvt_pk_bf16(kd8[0], kd8[1]); kw.y = cvt_pk_bf16(kd8[2], kd8[3]); kw.z = cvt_pk_bf16(kd8[4], kd8[5]); kw.w = cvt_pk_bf16(kd8[6], kd8[7]);
            *(LAS u32x4*)(lds + L_KDT + lane * P + 16 * w) = kw;
            if (w == 0) EB[lane] = __expf(total);
            u32x4 v0, v1;
            v0.x = (unsigned)vv[0] | ((unsigned)vv[1] << 16); v0.y = (unsigned)vv[2] | ((unsigned)vv[3] << 16); v0.z = (unsigned)vv[4] | ((unsigned)vv[5] << 16); v0.w = (unsigned)vv[6] | ((unsigned)vv[7] << 16);
            v1.x = (unsigned)vv[8] | ((unsigned)vv[9] << 16); v1.y = (unsigned)vv[10] | ((unsigned)vv[11] << 16); v1.z = (unsigned)vv[12] | ((unsigned)vv[13] << 16); v1.w = (unsigned)vv[14] | ((unsigned)vv[15] << 16);
            *(LAS u32x4*)(lds + L_VT + vc * P + 32 * tg2) = v0; *(LAS u32x4*)(lds + L_VT + vc * P + 32 * tg2 + 16) = v1;
        }
        __syncthreads();
        {
            const int mt = w >> 1;
#pragma unroll
            for (int q = 0; q < 2; ++q) {
                const int nt = 2 * (w & 1) + q; f32x4 a = (f32x4){0.f, 0.f, 0.f, 0.f};
                if (nt <= mt) {
#pragma unroll
                    for (int s = 0; s < 2; ++s) { const bf16x8 A = *(const LAS bf16x8*)(lds + L_QD + (16 * mt + l15) * P + 64 * s + 16 * kg), B = *(const LAS bf16x8*)(lds + L_KD + (16 * nt + l15) * P + 64 * s + 16 * kg); a = mfma16(A, B, a); }
                }
#pragma unroll
                for (int r = 0; r < 4; ++r) { const int i = 16 * mt + 4 * kg + r, j = 16 * nt + l15; const float v = (j <= i) ? a[r] : 0.f;
                    *(LAS bf16_t*)(lds + L_ATT + i * P + j * 2) = (bf16_t)(cvt_pk_bf16(v, 0.f) & 0xffffu); }
            }
        }
        __syncthreads();
        f32x4 o[4];
        {
            bf16x8 bv[2], bs[2];
#pragma unroll
            for (int s = 0; s < 2; ++s) { bv[s] = *(const LAS bf16x8*)(lds + L_VT + (16 * w + l15) * P + 64 * s + 16 * kg);
                u32x4 t; t.x = cvt_pk_bf16(S[2 * s][0], S[2 * s][1]); t.y = cvt_pk_bf16(S[2 * s][2], S[2 * s][3]); t.z = cvt_pk_bf16(S[2 * s + 1][0], S[2 * s + 1][1]); t.w = cvt_pk_bf16(S[2 * s + 1][2], S[2 * s + 1][3]); bs[s] = __builtin_bit_cast(bf16x8, t); }
#pragma unroll
            for (int mt = 0; mt < 4; ++mt) {
                f32x4 a = (f32x4){0.f, 0.f, 0.f, 0.f};
#pragma unroll
                for (int s = 0; s < 2; ++s) { const u32x2 lo = *(const LAS u32x2*)(lds + L_QD + (16 * mt + l15) * P + 64 * s + 8 * kg), hi2 = *(const LAS u32x2*)(lds + L_QD + (16 * mt + l15) * P + 64 * s + 32 + 8 * kg);
                    u32x4 t; t.x = lo.x; t.y = lo.y; t.z = hi2.x; t.w = hi2.y; a = mfma16(__builtin_bit_cast(bf16x8, t), bs[s], a); }
#pragma unroll
                for (int s = 0; s < 2; ++s) { const bf16x8 A = *(const LAS bf16x8*)(lds + L_ATT + (16 * mt + l15) * P + 64 * s + 16 * kg); a = mfma16(A, bv[s], a); }
                o[mt] = a;
            }
#pragma unroll
            for (int mt = 0; mt < 4; ++mt) {
                const f32x4 eb4 = *(const LAS f32x4*)(EB + 16 * mt + 4 * kg); f32x4 a = S[mt] * eb4;
#pragma unroll
                for (int s = 0; s < 2; ++s) { const bf16x8 A = *(const LAS bf16x8*)(lds + L_KDT + (16 * mt + l15) * P + 64 * s + 16 * kg); a = mfma16(A, bv[s], a); }
                S[mt] = a;
            }
        }
#pragma unroll
        for (int mt = 0; mt < 4; ++mt)
#pragma unroll
            for (int r = 0; r < 4; ++r) { float s = o[mt][r] * o[mt][r]; s += __shfl_xor(s, 1); s += __shfl_xor(s, 2); s += __shfl_xor(s, 4); s += __shfl_xor(s, 8);
                if (l15 == 0) SSQ[(16 * mt + 4 * kg + r) * 8 + w] = s; }
        __syncthreads();
        GAS bf16_t* gbase = (GAS bf16_t*)(ACAT + (row0 + 4 * kg) * 1024 + 512 + h * 128 + 16 * w + l15); asm volatile("" : "+v"(gbase));
#pragma unroll
        for (int mt = 0; mt < 4; ++mt)
#pragma unroll
            for (int r = 0; r < 4; ++r) { const int tok = 16 * mt + 4 * kg + r; const LAS f32x4* sp = (const LAS f32x4*)(SSQ + tok * 8); const f32x4 a = sp[0], c = sp[1];
                const float tot = ((a[0] + a[1]) + (a[2] + a[3])) + ((c[0] + c[1]) + (c[2] + c[3])); const float rs = rsq(tot * (1.f / 128.f) + EPS);
                GAS bf16_t* gp = gbase + (size_t)(16 * mt + r) * 1024; const float gate = bf1(*gp);
                *gp = (bf16_t)(cvt_pk_bf16(o[mt][r] * rs * gn * gate, 0.f) & 0xffffu); }
    }
    __syncthreads();
}
}

constexpr int NWAVES = 8;
#ifndef PHMASK
#define PHMASK 0x7ff
#endif
constexpr size_t MiB = 1u << 20;
constexpr size_t WS_CTL = 0, CTL_ZERO_BYTES = 1 * MiB;
constexpr size_t WS_WIN = 2 * MiB, WS_WUQ = 12 * MiB, WS_WUKV = 13 * MiB, WS_WCAT = 14 * MiB, WS_WOUT = 16 * MiB, WS_WPLE = 18 * MiB, WS_WPLEG = 19 * MiB;
constexpr size_t WS_ROPE = 22 * MiB, WS_SSQA = 26 * MiB, WS_SSQ1 = 30 * MiB, WS_SSQE = 32 * MiB, WS_SSQ2 = 34 * MiB;
constexpr size_t WS_PB = 36 * MiB, WS_ACAT = 52 * MiB, WS_SMA = 116 * MiB, WS_SMB = 180 * MiB;
constexpr size_t WS_S1 = 244 * MiB;
constexpr size_t WS_S2 = 308 * MiB;
constexpr size_t WS_S3 = 372 * MiB;
constexpr size_t WS_Q = 444 * MiB, WS_END = 492 * MiB;
constexpr size_t WS_H = WS_S1, WS_KV = WS_S1, WS_MERGED = WS_S1;
constexpr size_t WS_CQ = WS_S2, WS_CKV = WS_S2 + 24 * MiB, WS_X1B = WS_S2;
constexpr size_t WS_GQ = WS_S3, WS_GK = WS_S3 + 16 * MiB, WS_GV = WS_S3 + 32 * MiB, WS_SMALL = WS_S3 + 64 * MiB, WS_E = WS_S3;
constexpr int CW_BAR = 4096;
constexpr int CW_Q = 16384;
constexpr int RING_OFF = 0, RING_BYTES = 131072;
constexpr int LDSCTL_OFF = RING_BYTES, MISC_OFF = LDSCTL_OFF + 320;
constexpr int LDS_BYTES = 147456;
static_assert(att::L_END <= RING_BYTES && gla::L_END <= RING_BYTES && MISC_OFF + 128 <= LDS_BYTES, "LDS map");

typedef GAS unsigned gu32;
#define RLX_AGENT __ATOMIC_RELAXED, __HIP_MEMORY_SCOPE_AGENT
#define LDS_WAIT() asm volatile("s_waitcnt lgkmcnt(0)" ::: "memory")
#define VM_WAIT() asm volatile("s_waitcnt vmcnt(0)" ::: "memory")

#define XB_TMO      128
#define XB_XCNT(j)  (256  + 64 * (j))
#define XB_XSUB(j)  (1280 + 64 * (j))
#define XB_XGEN(j)  (2304 + 64 * (j))
#define XB_TOP      3328
#define XB_TOPGEN   3392
#define XCD_BAR_WORDS 3456
#define XB_SPIN_CAP (1u << 18)
__device__ __forceinline__ unsigned xb_ld(unsigned* p)              { return __hip_atomic_load(p, __ATOMIC_RELAXED, __HIP_MEMORY_SCOPE_AGENT); }
__device__ __forceinline__ unsigned xb_add(unsigned* p, unsigned v) { return __hip_atomic_fetch_add(p, v, __ATOMIC_RELAXED, __HIP_MEMORY_SCOPE_AGENT); }
__device__ __forceinline__ unsigned xb_xcc_id() { return (unsigned)__builtin_amdgcn_s_getreg((3 << 11) | 20) & 0xFu; }
#define XB_SPIN(cond, bar) do { unsigned _sp = 0; while (cond) { __builtin_amdgcn_s_sleep(1); \
    if ((++_sp & 255u) == 0u) { if (xb_ld(&(bar)[XB_TMO])) break; if (_sp > XB_SPIN_CAP) { atomicAdd(&(bar)[XB_TMO], 1u); break; } } } } while (0)
struct XcdBarrier { unsigned* bar; unsigned x; volatile LAS unsigned* st; };
__device__ __forceinline__ XcdBarrier xcd_barrier_post(unsigned* bar, volatile LAS unsigned* st) {
    XcdBarrier b; b.bar = bar; b.x = xb_xcc_id(); b.st = st;
    if (threadIdx.x == 0) (void)xb_add(&bar[XB_XCNT(b.x)], 1u);
    return b;
}
__device__ __forceinline__ void xcd_barrier_complete(unsigned* bar, unsigned x, unsigned& nloc, unsigned& nx) {
    const unsigned G = gridDim.x * gridDim.y * gridDim.z;
    unsigned sum, cnt, mine, sp = 0u;
    for (;;) {
        sum = 0u; cnt = 0u; mine = 0u;
#pragma unroll
        for (unsigned j = 0; j < 16; ++j) { const unsigned c = xb_ld(&bar[XB_XCNT(j)]); sum += c; cnt += (c > 0u) ? 1u : 0u; mine = (j == x) ? c : mine; }
        if (sum == G) break;
        __builtin_amdgcn_s_sleep(1);
        if ((++sp & 255u) == 0u) { if (xb_ld(&bar[XB_TMO])) break; if (sp > XB_SPIN_CAP) { atomicAdd(&bar[XB_TMO], 1u); break; } }
    }
    nloc = mine > 0u ? mine : 1u; nx = cnt > 0u ? cnt : 1u;
}
__device__ __forceinline__ void xcd_barrier(const XcdBarrier& b) {
    asm volatile("s_waitcnt vmcnt(0)" ::: "memory");
    __syncthreads();
    if (threadIdx.x == 0) {
        unsigned* bar = b.bar;
        __builtin_amdgcn_s_waitcnt(0);
        unsigned nloc = b.st[0], nx = b.st[1];
        if (nloc == 0u) { xcd_barrier_complete(bar, b.x, nloc, nx); b.st[0] = nloc; b.st[1] = nx; }
        const unsigned old = xb_add(&bar[XB_XSUB(b.x)], 1u);
        const unsigned gen = old / nloc;
        if (old + 1u == (gen + 1u) * nloc) {
            __builtin_amdgcn_fence(__ATOMIC_RELEASE, "agent");
            asm volatile("s_waitcnt vmcnt(0)" ::: "memory");
            const unsigned og = xb_add(&bar[XB_TOP], 1u);
            const unsigned tg = og / nx;
            if (og + 1u == (tg + 1u) * nx) xb_add(&bar[XB_TOPGEN], 1u);
            else XB_SPIN(xb_ld(&bar[XB_TOPGEN]) == tg, bar);
            __builtin_amdgcn_fence(__ATOMIC_ACQUIRE, "agent");
            xb_add(&bar[XB_XGEN(b.x)], 1u);
            asm volatile("s_waitcnt vmcnt(0)" ::: "memory");
        } else {
            XB_SPIN(xb_ld(&bar[XB_XGEN(b.x)]) == gen, bar);
            __builtin_amdgcn_fence(__ATOMIC_ACQUIRE, "agent");
            asm volatile("s_waitcnt vmcnt(0)" ::: "memory");
        }
    }
    __syncthreads();
}

__device__ __forceinline__ float wave_sum(float v) {
#pragma unroll
    for (int o = 1; o < 64; o <<= 1) v += __shfl_xor(v, o);
    return v;
}
__device__ __forceinline__ int rope_pinv(int i) { return (i < 16) ? (8 * (i >> 2) + (i & 3)) : (8 * ((i - 16) >> 2) + 4 + (i & 3)); }
__device__ __forceinline__ int map_win(int n) {
    if (n < 384) return n;
    if (n < 640) return n;
    if (n < 672) return 4736 + rope_pinv(n - 640);
    if (n < 1184) return 1664 + (n - 672);
    if (n < 1440) return 640 + (n - 1184);
    if (n < 1696) return 896 + (n - 1440);
    if (n < 2208) return 1152 + (n - 1696);
    if (n < 2224) return 4768 + (n - 2208);
    if (n < 2736) return 2176 + (n - 2224);
    if (n < 3760) return 2688 + (n - 2736);
    return 3712 + (n - 3760);
}
__device__ __forceinline__ int map_wuq(int n) { const int hh = n / 96, r = n % 96; return (r < 64) ? n : hh * 96 + 64 + rope_pinv(r - 64); }
template <int MAP> __device__ __forceinline__ void p0_transpose_item(const float* W, int K, int N, bf16_t* WT, int ldk, int kcol_off, const float* gain, LAS float* scr, int item, int lane) {
    const int nblk = (N + 31) / 32, kb = item / nblk, nb = item % nblk, k0 = 64 * kb, n0 = 32 * nb;
    const bool inb = (n0 + (lane & 31)) < N;
#pragma unroll 8
    for (int i = 0; i < 32; ++i) { const int kk = 2 * i + (lane >> 5); float v = inb ? W[(size_t)(k0 + kk) * N + n0 + (lane & 31)] : 0.f; if (gain) v *= gain[k0 + kk]; scr[kk * 33 + (lane & 31)] = v; }
    LDS_WAIT(); asm volatile("" ::: "memory");
    const int c = lane & 7;
#pragma unroll
    for (int j = 0; j < 4; ++j) { const int n = (lane >> 3) + 8 * j; const LAS float* s = scr + (8 * c) * 33 + n;
        u32x4 o; o.x = cvt_pk_bf16(s[0 * 33], s[1 * 33]); o.y = cvt_pk_bf16(s[2 * 33], s[3 * 33]); o.z = cvt_pk_bf16(s[4 * 33], s[5 * 33]); o.w = cvt_pk_bf16(s[6 * 33], s[7 * 33]);
        const int ns = n0 + n;
        if (ns < N) { const int nd = (MAP == 1) ? map_win(ns) : (MAP == 2) ? map_wuq(ns) : ns; *(GAS u32x4*)(WT + (size_t)nd * ldk + kcol_off + k0 + 8 * c) = o; } }
    LDS_WAIT(); asm volatile("" ::: "memory");
}

__device__ const float ROPE_INVF[16] = {1.0f, 0.5623413324356079f, 0.3162277638912201f, 0.17782793939113617f, 0.10000000149011612f, 0.05623412877321243f, 0.03162277862429619f, 0.017782794311642647f,
    0.009999999776482582f, 0.005623413249850273f, 0.003162277862429619f, 0.0017782794311642647f, 0.0010000000474974513f, 0.000562341301701963f, 0.0003162277862429619f, 0.00017782794020604342f};

struct Args { const void* in[20]; float* out; unsigned char* ws; };
#define IN_F(k) ((const float*)args.in[k])
#define WSB(off) ((bf16_t*)(args.ws + (off)))
#define WSF(off) ((float*)(args.ws + (off)))


__global__ void __launch_bounds__(NWAVES * 64, 2) hybrid_fwd(Args args) {
    extern __shared__ __attribute__((aligned(16))) unsigned char lds_raw[];
    LAS unsigned char* lds = (LAS unsigned char*)lds_raw;
    volatile LAS unsigned* MISC = (volatile LAS unsigned*)(lds + MISC_OFF);
    const int tid = threadIdx.x, lane = tid & 63, wave = __builtin_amdgcn_readfirstlane(tid >> 6);
    const int G = gridDim.x; const int bx = blockIdx.x; const int vcu = (G % 8 == 0) ? (bx % 8) * (G / 8) + bx / 8 : bx;
    gu32* ctl = (gu32*)(args.ws + WS_CTL);
    for (int u = tid; u < (LDS_BYTES - LDSCTL_OFF) / 4; u += NWAVES * 64) ((LAS unsigned*)(lds + LDSCTL_OFF))[u] = 0u;
    __syncthreads();
    XcdBarrier bar = xcd_barrier_post((unsigned*)(ctl + CW_BAR), MISC + 8);
#define GRID_BAR() xcd_barrier(bar)

    if (PHMASK & 1) {
        LAS float* scr = (LAS float*)(lds + RING_OFF + wave * 16384);
        const int gw = vcu * NWAVES + wave, NGW = G * NWAVES;
        constexpr int I_IN = (1024 / 64) * ((NIN_REAL + 31) / 32), I_UQ = (384 / 64) * (768 / 32), I_UKV = (256 / 64) * (1024 / 32), I_BR = (512 / 64) * (1024 / 32),
                      I_OUT = (1024 / 64) * (1024 / 32), I_PLE = (256 / 64) * (1024 / 32), I_PLEG = I_OUT;
        constexpr int NITEMS = I_IN + I_UQ + I_UKV + 2 * I_BR + I_OUT + I_PLE + I_PLEG;
        for (int it = gw; it < NITEMS; it += NGW) {
            int r = it;
            if (r < I_IN) { p0_transpose_item<1>(IN_F(4), 1024, NIN_REAL, WSB(WS_WIN), 1024, 0, nullptr, scr, r, lane); continue; } r -= I_IN;
            if (r < I_UQ) { p0_transpose_item<2>(IN_F(6), 384, 768, WSB(WS_WUQ), 384, 0, IN_F(5), scr, r, lane); continue; } r -= I_UQ;
            if (r < I_UKV) { p0_transpose_item<0>(IN_F(8), 256, 1024, WSB(WS_WUKV), 256, 0, IN_F(7), scr, r, lane); continue; } r -= I_UKV;
            if (r < I_BR) { p0_transpose_item<0>(IN_F(12), 512, 1024, WSB(WS_WCAT), 1024, 0, nullptr, scr, r, lane); continue; } r -= I_BR;
            if (r < I_BR) { p0_transpose_item<0>(IN_F(13), 512, 1024, WSB(WS_WCAT), 1024, 512, nullptr, scr, r, lane); continue; } r -= I_BR;
            if (r < I_OUT) { p0_transpose_item<0>(IN_F(14), 1024, 1024, WSB(WS_WOUT), 1024, 0, nullptr, scr, r, lane); continue; } r -= I_OUT;
            if (r < I_PLE) { p0_transpose_item<0>(IN_F(15), 256, 1024, WSB(WS_WPLE), 256, 0, nullptr, scr, r, lane); continue; } r -= I_PLE;
            p0_transpose_item<0>(IN_F(18), 1024, 1024, WSB(WS_WPLEG), 1024, 0, IN_F(17), scr, r, lane);
        }
        { const int gt = vcu * (NWAVES * 64) + tid, NT_ = G * NWAVES * 64; const int npad = (NIN - NIN_REAL) * 1024 / 8; bf16_t* W_IN = WSB(WS_WIN);
          for (int i = gt; i < npad; i += NT_) *(GAS u32x4*)(W_IN + (size_t)NIN_REAL * 1024 + (size_t)i * 8) = (u32x4){0u, 0u, 0u, 0u}; }
        { const float* x = IN_F(0); const float* p_in = IN_F(1); const float* norm_in_g = IN_F(3); bf16_t* HB = WSB(WS_H); bf16_t* PB = WSB(WS_PB);
        for (int m = gw; m < M; m += NGW) {
            const GAS f32x4* xr = (const GAS f32x4*)(x + (size_t)m * D) + lane;
            f32x4 v[4]; float s2 = 0.f;
#pragma unroll
            for (int j = 0; j < 4; ++j) { v[j] = xr[64 * j]; s2 += (v[j][0] * v[j][0] + v[j][1] * v[j][1]) + (v[j][2] * v[j][2] + v[j][3] * v[j][3]); }
            const float rs = rsq(wave_sum(s2) * (1.f / D) + EPS);
            GAS u32x2* o8 = (GAS u32x2*)(HB + (size_t)m * D) + lane;
#pragma unroll
            for (int j = 0; j < 4; ++j) { const f32x4 gg = *((const GAS f32x4*)norm_in_g + lane + 64 * j); u32x2 w2; w2.x = cvt_pk_bf16(v[j][0] * rs * gg[0], v[j][1] * rs * gg[1]); w2.y = cvt_pk_bf16(v[j][2] * rs * gg[2], v[j][3] * rs * gg[3]); o8[64 * j] = w2; }
            const f32x4 pv = *((const GAS f32x4*)(p_in + (size_t)m * 256) + lane);
            u32x2 pw; pw.x = cvt_pk_bf16(pv[0], pv[1]); pw.y = cvt_pk_bf16(pv[2], pv[3]); *((GAS u32x2*)(PB + (size_t)m * 256) + lane) = pw;
        } }
        { const int gt = vcu * (NWAVES * 64) + tid, NT_ = G * NWAVES * 64; const int* positions = (const int*)args.in[2]; float* ROPE = WSF(WS_ROPE);
          for (int i = gt; i < M * 16; i += NT_) { const int m = i >> 4, k = i & 15; const float ang = (float)positions[m] * ROPE_INVF[k];
              const double rev = (double)ang * 0.15915494309189535; const double fr = rev - __builtin_rint(rev); const float f = (float)fr;
              ROPE[2 * (size_t)i] = __builtin_amdgcn_cosf(f); ROPE[2 * (size_t)i + 1] = __builtin_amdgcn_sinf(f); } }
    }
    GRID_BAR();

    if (PHMASK & 2) {
        pg8::Gemm g{WSB(WS_H), WSB(WS_WIN), M, NIN, 1024, 1024}; pg8::StaticOrder S; S.init(M, NIN, G, bx);
        pg8::EpiProj E{WSB(WS_CQ), WSB(WS_CKV), WSB(WS_GQ), WSB(WS_GK), WSB(WS_GV), WSB(WS_ACAT), WSB(WS_SMA), WSB(WS_SMB), WSB(WS_SMALL), WSF(WS_SSQA), WSF(WS_ROPE)};
        pg8::gemm_phase<pg8::EpiProj, pg8::StaticOrder, true, true>(lds + RING_OFF, g, S, E);
    }
    GRID_BAR();

    if (PHMASK & 4) {
        pg8::Gemm g{WSB(WS_CQ), WSB(WS_WUQ), M, 768, 384, 384}; pg8::StaticOrder S; S.init(M, 768, G, bx);
        pg8::EpiQ E{WSB(WS_Q), WSF(WS_SSQA), WSF(WS_ROPE)};
        pg8::gemm_phase<pg8::EpiQ, pg8::StaticOrder, true, true>(lds + RING_OFF, g, S, E);
    }
    if (PHMASK & 8) {
        pg8::Gemm g{WSB(WS_CKV), WSB(WS_WUKV), M, 1024, 256, 256}; pg8::StaticOrder S; S.init(M, 1024, G, bx);
        pg8::EpiKV E{WSB(WS_KV), WSF(WS_SSQA)};
        pg8::gemm_phase<pg8::EpiKV, pg8::StaticOrder, true, true>(lds + RING_OFF, g, S, E);
    }
    GRID_BAR();

    if (PHMASK & 0x30) {
        const int myq = (int)(bar.x & 7u);
        for (int dq = 0; dq < 8; ++dq) {
            const int qj = (myq + dq) & 7;
            for (;;) {
                if (tid == 0) MISC[4] = __hip_atomic_fetch_add((unsigned*)(ctl + CW_Q + 64 * qj), 1u, RLX_AGENT);
                __syncthreads();
                const int it = (int)MISC[4];
                __syncthreads();
                if (it >= 136) break;
                if (it < 8) { if (PHMASK & 0x10) gla::gla_item(qj + 8 * it, WSB(WS_GQ), WSB(WS_GK), WSB(WS_GV), WSB(WS_SMALL), IN_F(9), IN_F(10), IN_F(11), WSB(WS_ACAT), lds + RING_OFF); }
                else if (PHMASK & 0x20) { const int a = it - 8; att::attn_unit(a & 15, qj, 7 - (a >> 4), WSB(WS_Q), WSB(WS_KV), WSB(WS_SMALL), WSB(WS_ACAT), lds + RING_OFF); }
            }
        }
    }
    GRID_BAR();

    if (PHMASK & 0x40) {
        pg8::Gemm g{WSB(WS_ACAT), WSB(WS_WCAT), M, 1024, 1024, 1024}; pg8::StaticOrder S; S.init(M, 1024, G, bx);
        pg8::EpiMerge E{WSB(WS_SMA), WSB(WS_SMB), WSB(WS_MERGED)};
        pg8::gemm_phase<pg8::EpiMerge, pg8::StaticOrder, true, true>(lds + RING_OFF, g, S, E);
    }
    GRID_BAR();

    if (PHMASK & 0x80) {
        pg8::Gemm g{WSB(WS_MERGED), WSB(WS_WOUT), M, 1024, 1024, 1024}; pg8::StaticOrder S; S.init(M, 1024, G, bx);
        pg8::EpiX1 E{IN_F(0), args.out, WSB(WS_X1B), WSF(WS_SSQ1)};
        pg8::gemm_phase<pg8::EpiX1, pg8::StaticOrder, true, true>(lds + RING_OFF, g, S, E);
    }
    if (PHMASK & 0x100) {
        pg8::Gemm g{WSB(WS_PB), WSB(WS_WPLE), M, 1024, 256, 256}; pg8::StaticOrder S; S.init(M, 1024, G, bx);
        pg8::EpiE E{WSB(WS_E), WSF(WS_SSQE)};
        pg8::gemm_phase<pg8::EpiE, pg8::StaticOrder, true, true>(lds + RING_OFF, g, S, E);
    }
    GRID_BAR();

    if (PHMASK & 0x200) {
        pg8::Gemm g{WSB(WS_X1B), WSB(WS_WPLEG), M, 1024, 1024, 1024}; pg8::StaticOrder S; S.init(M, 1024, G, bx);
        pg8::EpiG E{WSF(WS_SSQ1), WSF(WS_SSQE), WSB(WS_E), IN_F(16), args.out, WSF(WS_SSQ2)};
        pg8::gemm_phase<pg8::EpiG, pg8::StaticOrder, true, true>(lds + RING_OFF, g, S, E);
    }
    GRID_BAR();

    if (PHMASK & 0x400) {
        const int gw = vcu * NWAVES + wave, NGW = G * NWAVES;
        const unsigned tmo = __hip_atomic_load((unsigned*)(ctl + CW_BAR) + XB_TMO, RLX_AGENT);
        const float* final_norm_g = IN_F(19); float* out = args.out; const float* SSQ2 = WSF(WS_SSQ2);
        for (int m = gw; m < M; m += NGW) {
            const float sv = (lane < 16) ? SSQ2[(size_t)m * 16 + lane] : 0.f;
            float rs = rsq(wave_sum(sv) * (1.f / D) + EPS);
            if (tmo) rs = __builtin_nanf("");
            GAS f32x4* xr = (GAS f32x4*)(out + (size_t)m * D) + lane;
#pragma unroll
            for (int j = 0; j < 4; ++j) { const f32x4 gg = *((const GAS f32x4*)final_norm_g + lane + 64 * j); f32x4 v = xr[64 * j]; v = v * rs * gg; xr[64 * j] = v; }
        }
    }
}

extern "C" void kernel_launch(void* const* d_in, const int* in_sizes, int n_in, void* d_out, int out_size, void* d_ws, size_t ws_size, hipStream_t stream) {
    static int grid = 0;
    if (grid == 0) {
        if (n_in != 20 || in_sizes[0] != M * D || out_size != M * D || ws_size < WS_END) {
            fprintf(stderr, "kernel_launch: unexpected shapes (n_in %d, in0 %d, out %d, ws %zu; need ws >= %zu); nothing launched\n", n_in, n_in > 0 ? in_sizes[0] : -1, out_size, ws_size, (size_t)WS_END); grid = -1; return; }
        int dev = 0, cus = 0, per_cu = 0;
        if (hipGetDevice(&dev) != hipSuccess || hipDeviceGetAttribute(&cus, hipDeviceAttributeMultiprocessorCount, dev) != hipSuccess) { fprintf(stderr, "kernel_launch: device query failed\n"); grid = -1; return; }
        if (hipFuncSetAttribute((const void*)hybrid_fwd, hipFuncAttributeMaxDynamicSharedMemorySize, LDS_BYTES) != hipSuccess) { fprintf(stderr, "kernel_launch: hipFuncSetAttribute failed\n"); grid = -1; return; }
        if (hipOccupancyMaxActiveBlocksPerMultiprocessor(&per_cu, (const void*)hybrid_fwd, NWAVES * 64, LDS_BYTES) != hipSuccess || per_cu < 1)
            fprintf(stderr, "kernel_launch: note: occupancy query reports %d workgroups per CU\n", per_cu);
        (void)hipGetLastError();
        grid = cus;
    }
    if (grid < 0) return;
    if (hipMemsetAsync((char*)d_ws + WS_CTL, 0, CTL_ZERO_BYTES, stream) != hipSuccess) { fprintf(stderr, "kernel_launch: hipMemsetAsync failed\n"); return; }
    Args a{};
    for (int i = 0; i < 20; ++i) a.in[i] = d_in[i];
    a.out = (float*)d_out; a.ws = (unsigned char*)d_ws;
    hipLaunchKernelGGL(hybrid_fwd, dim3(grid), dim3(NWAVES * 64), LDS_BYTES, stream, a);
    const hipError_t le = hipPeekAtLastError();
    if (le != hipSuccess) fprintf(stderr, "kernel_launch: launch failed: %s\n", hipGetErrorName(le));
}
```

```cpp
#include <hip/hip_runtime.h>
#include <hip/hip_bf16.h>
#include <cstdio>
#include <cstdint>
#include <cmath>

#define LAS __attribute__((address_space(3)))
#define GAS __attribute__((address_space(1)))
typedef unsigned short bf16_t;
typedef short bf16x8 __attribute__((ext_vector_type(8)));
typedef short s16x4 __attribute__((ext_vector_type(4)));
typedef float f32x4 __attribute__((ext_vector_type(4)));
typedef float f32x16 __attribute__((ext_vector_type(16)));
typedef unsigned u32x4 __attribute__((ext_vector_type(4)));
typedef unsigned u32x2 __attribute__((ext_vector_type(2)));

constexpr int NB = 16, SEQ = 2048, M = NB * SEQ, D = 1024;
constexpr int NIN = 4864;
constexpr int NIN_REAL = 4784;
constexpr float EPS = 1e-6f;
constexpr float LOG2E = 1.4426950408889634f;
constexpr float C2Q = 0.10206207261596577f * LOG2E;

__device__ __forceinline__ unsigned cvt_pk_bf16(float lo, float hi) { unsigned r; asm volatile("v_cvt_pk_bf16_f32 %0, %1, %2" : "=v"(r) : "v"(lo), "v"(hi)); return r; }
__device__ __forceinline__ float bflo(unsigned w) { return __uint_as_float(w << 16); }
__device__ __forceinline__ float bfhi(unsigned w) { return __uint_as_float(w & 0xffff0000u); }
__device__ __forceinline__ float bf1(bf16_t b) { return __uint_as_float((unsigned)b << 16); }
__device__ __forceinline__ float sigm(float x) { return __builtin_amdgcn_rcpf(1.f + __builtin_amdgcn_exp2f(-LOG2E * x)); }
__device__ __forceinline__ float rsq(float x) { return __builtin_amdgcn_rsqf(x); }

namespace pg8 {
constexpr int BM = 256, BK = 64, HALF = 128, HTB = HALF * BK * 2, STAGE_BYTES = 8 * HTB, NXCD = 8, WGM = 8;
__host__ __device__ __forceinline__ int lds_byte(int r, int c) { const int st = (r >> 4) * 2 + (c >> 5), rr = r & 15, cc = c & 31, ob = rr * 64 + cc * 2; return st * 1024 + (ob ^ (((ob >> 9) & 1) << 5)); }
__host__ __device__ __forceinline__ void stage_rc(int b, int& R, int& C) { const int st = b / 1024, sb = b % 1024, swz = sb ^ (((sb >> 9) & 1) << 5); R = (st >> 1) * 16 + swz / 64; C = (st & 1) * 32 + (swz % 64) / 2; }
__host__ __device__ __forceinline__ int perm32(int rho) { const int n = rho >> 4, i = rho & 15; return 8 * (i >> 2) + 4 * n + (i & 3); }

struct Unit { int pm, pn; };
struct Gemm { const bf16_t* A; const bf16_t* Bt; int M, N, K, lda; };

struct StaticOrder {
    int nM, nN, nwg, G, c;
    __host__ __device__ void init(int M_, int N_, int G_, int c_) { nM = M_ / BM; nN = N_ / BM; nwg = nM * nN; G = G_; c = c_; }
    __host__ __device__ bool next(int i, Unit& u) const {
        const long L = (long)i * G + c; if (L >= nwg) return false;
        int wgid = (int)L; { const int q = nwg / NXCD, r = nwg % NXCD, xcd = wgid % NXCD, off = wgid / NXCD; wgid = (xcd < r ? xcd * (q + 1) : r * (q + 1) + (xcd - r) * q) + off; }
        const int nig = WGM * nN, gid = wgid / nig, fm = gid * WGM, gsz = (nM - fm) < WGM ? (nM - fm) : WGM;
        u.pm = fm + ((wgid % nig) % gsz); u.pn = (wgid % nig) / gsz; return true;
    }
};

typedef f32x4 Acc[2][2][4][2];

__device__ __forceinline__ float sum8sq(const f32x4& a, const f32x4& b) { return (a[0] * a[0] + a[1] * a[1]) + (a[2] * a[2] + a[3] * a[3]) + (b[0] * b[0] + b[1] * b[1]) + (b[2] * b[2] + b[3] * b[3]); }
__device__ __forceinline__ float red_fq(float s) { s += __shfl_xor(s, 16); s += __shfl_xor(s, 32); return s; }
__device__ __forceinline__ u32x4 pack8(const f32x4& a, const f32x4& b) { u32x4 w; w.x = cvt_pk_bf16(a[0], a[1]); w.y = cvt_pk_bf16(a[2], a[3]); w.z = cvt_pk_bf16(b[0], b[1]); w.w = cvt_pk_bf16(b[2], b[3]); return w; }

struct EpiProj {
    static constexpr bool PERM = true, HAS_MID = false;
    bf16_t *cq, *ckv, *gq, *gk, *gv, *acat, *sma, *smb, *small; float* ssqa; const float* rope;
    __device__ __forceinline__ void mid(Acc&, const Unit&, int, int, int, int) const {}
    __device__ __forceinline__ void operator()(const Acc& acc, const Unit& u, int wr, int wc, int fr, int fq) const {
#pragma unroll
        for (int bj = 0; bj < 2; ++bj) {
            const int hb = 2 * u.pn + bj;
            bf16_t* dst; int ldc, coff, act = 0;
            if (hb < 3) { dst = cq; ldc = 384; coff = hb * 128; }
            else if (hb < 5) { dst = ckv; ldc = 256; coff = (hb - 3) * 128; }
            else if (hb < 7) { dst = gq; ldc = 256; coff = (hb - 5) * 128; }
            else if (hb < 9) { dst = gk; ldc = 256; coff = (hb - 7) * 128; }
            else if (hb < 13) { dst = gv; ldc = 512; coff = (hb - 9) * 128; }
            else if (hb < 21) { dst = acat; ldc = 1024; coff = (hb - 13) * 128; act = 1; }
            else if (hb < 29) { dst = sma; ldc = 1024; coff = (hb - 21) * 128; act = 2; }
            else if (hb < 37) { dst = smb; ldc = 1024; coff = (hb - 29) * 128; act = 2; }
            else { dst = small; ldc = 128; coff = 0; act = (wc == 0) ? 3 : 0; }
            const bool dosq = hb < 5;
#pragma unroll
            for (int ai = 0; ai < 2; ++ai)
#pragma unroll
                for (int m = 0; m < 4; ++m) {
                    const int row = u.pm * BM + ai * HALF + wr * 64 + m * 16 + fr;
                    f32x4 v0 = acc[ai][bj][m][0], v1 = acc[ai][bj][m][1];
                    if (dosq) { const float s = red_fq(sum8sq(v0, v1)); if (fq == 0) ssqa[(size_t)row * 32 + hb * 4 + wc] = s; }
                    if (act == 1) {
#pragma unroll
                        for (int e = 0; e < 4; ++e) { v0[e] = v0[e] * sigm(v0[e]); v1[e] = v1[e] * sigm(v1[e]); }
                    } else if (act == 2) {
#pragma unroll
                        for (int e = 0; e < 4; ++e) { v0[e] = sigm(v0[e]); v1[e] = sigm(v1[e]); }
                    } else if (act == 3) {
                        const f32x4* rp = (const f32x4*)(rope + (size_t)row * 32 + 8 * fq); const f32x4 r0 = rp[0], r1 = rp[1];
                        const float c[4] = {r0[0], r0[2], r1[0], r1[2]}, s[4] = {r0[1], r0[3], r1[1], r1[3]};
#pragma unroll
                        for (int e = 0; e < 4; ++e) { const float x1 = v0[e], x2 = v1[e]; v0[e] = x1 * c[e] - x2 * s[e]; v1[e] = x2 * c[e] + x1 * s[e]; }
                    }
                    *(u32x4*)(dst + (size_t)row * ldc + coff + wc * 32 + 8 * fq) = pack8(v0, v1);
                }
        }
    }
};

struct EpiQ {
    static constexpr bool PERM = true, HAS_MID = false;
    bf16_t* q; const float* ssqa; const float* rope;
    __device__ __forceinline__ void mid(Acc&, const Unit&, int, int, int, int) const {}
    __device__ __forceinline__ void operator()(const Acc& acc, const Unit& u, int wr, int wc, int fr, int fq) const {
#pragma unroll
        for (int ai = 0; ai < 2; ++ai)
#pragma unroll
            for (int m = 0; m < 4; ++m) {
                const int row = u.pm * BM + ai * HALF + wr * 64 + m * 16 + fr;
                const f32x4* sp = (const f32x4*)(ssqa + (size_t)row * 32); const f32x4 a = sp[0], b = sp[1], c = sp[2];
                const float tot = ((a[0] + a[1]) + (a[2] + a[3])) + ((b[0] + b[1]) + (b[2] + b[3])) + ((c[0] + c[1]) + (c[2] + c[3]));
                const float rs = rsq(tot * (1.f / 384.f) + EPS) * C2Q;
#pragma unroll
                for (int bj = 0; bj < 2; ++bj) {
                    const int grp = 8 * u.pn + 4 * bj + wc;
                    f32x4 v0 = acc[ai][bj][m][0] * rs, v1 = acc[ai][bj][m][1] * rs;
                    if ((grp % 3) == 2) {
                        const f32x4* rp = (const f32x4*)(rope + (size_t)row * 32 + 8 * fq); const f32x4 r0 = rp[0], r1 = rp[1];
                        const float cc[4] = {r0[0], r0[2], r1[0], r1[2]}, ss[4] = {r0[1], r0[3], r1[1], r1[3]};
#pragma unroll
                        for (int e = 0; e < 4; ++e) { const float x1 = v0[e], x2 = v1[e]; v0[e] = x1 * cc[e] - x2 * ss[e]; v1[e] = x2 * cc[e] + x1 * ss[e]; }
                    }
                    *(u32x4*)(q + (size_t)row * 768 + u.pn * BM + bj * HALF + wc * 32 + 8 * fq) = pack8(v0, v1);
                }
            }
    }
};
struct EpiKV {
    static constexpr bool PERM = true, HAS_MID = false;
    bf16_t* kv; const float* ssqa;
    __device__ __forceinline__ void mid(Acc&, const Unit&, int, int, int, int) const {}
    __device__ __forceinline__ void operator()(const Acc& acc, const Unit& u, int wr, int wc, int fr, int fq) const {
#pragma unroll
        for (int ai = 0; ai < 2; ++ai)
#pragma unroll
            for (int m = 0; m < 4; ++m) {
                const int row = u.pm * BM + ai * HALF + wr * 64 + m * 16 + fr;
                const f32x4* sp = (const f32x4*)(ssqa + (size_t)row * 32 + 12); const f32x4 a = sp[0], b = sp[1];
                const float tot = ((a[0] + a[1]) + (a[2] + a[3])) + ((b[0] + b[1]) + (b[2] + b[3]));
                const float rs = rsq(tot * (1.f / 256.f) + EPS);
#pragma unroll
                for (int bj = 0; bj < 2; ++bj) {
                    const f32x4 v0 = acc[ai][bj][m][0] * rs, v1 = acc[ai][bj][m][1] * rs;
                    *(u32x4*)(kv + (size_t)row * 1024 + u.pn * BM + bj * HALF + wc * 32 + 8 * fq) = pack8(v0, v1);
                }
            }
    }
};
struct EpiMerge {
    static constexpr bool PERM = true, HAS_MID = true;
    const bf16_t* sma; const bf16_t* smb; bf16_t* out;
    __device__ __forceinline__ void mid(Acc& acc, const Unit& u, int wr, int wc, int fr, int fq) const {
#pragma unroll
        for (int ai = 0; ai < 2; ++ai)
#pragma unroll
            for (int m = 0; m < 4; ++m) {
                const int row = u.pm * BM + ai * HALF + wr * 64 + m * 16 + fr;
#pragma unroll
                for (int bj = 0; bj < 2; ++bj) {
                    const size_t off = (size_t)row * 1024 + u.pn * BM + bj * HALF + wc * 32 + 8 * fq;
                    const u32x4 a = *(const u32x4*)(sma + off), b = *(const u32x4*)(smb + off);
#pragma unroll
                    for (int e = 0; e < 4; ++e) {
                        const unsigned aw = a[e], bw = b[e];
                        const float r0 = bflo(aw) * __builtin_amdgcn_rcpf(bflo(bw)), r1 = bfhi(aw) * __builtin_amdgcn_rcpf(bfhi(bw));
                        acc[ai][bj][m][e >> 1][(e & 1) * 2] *= r0; acc[ai][bj][m][e >> 1][(e & 1) * 2 + 1] *= r1;
                    }
                }
                asm volatile("" ::: "memory");
            }
    }
    __device__ __forceinline__ void operator()(const Acc& acc, const Unit& u, int wr, int wc, int fr, int fq) const {
#pragma unroll
        for (int ai = 0; ai < 2; ++ai)
#pragma unroll
            for (int m = 0; m < 4; ++m) {
                const int row = u.pm * BM + ai * HALF + wr * 64 + m * 16 + fr;
#pragma unroll
                for (int bj = 0; bj < 2; ++bj) {
                    const size_t off = (size_t)row * 1024 + u.pn * BM + bj * HALF + wc * 32 + 8 * fq;
                    const u32x4 b = *(const u32x4*)(smb + off);
                    f32x4 v0 = acc[ai][bj][m][0], v1 = acc[ai][bj][m][1];
                    v0[0] *= bflo(b[0]); v0[1] *= bfhi(b[0]); v0[2] *= bflo(b[1]); v0[3] *= bfhi(b[1]);
                    v1[0] *= bflo(b[2]); v1[1] *= bfhi(b[2]); v1[2] *= bflo(b[3]); v1[3] *= bfhi(b[3]);
                    *(u32x4*)(out + off) = pack8(v0, v1);
                }
            }
    }
};
struct EpiX1 {
    static constexpr bool PERM = true, HAS_MID = false;
    const float* x; float* x1; bf16_t* x1b; float* ssq1;
    __device__ __forceinline__ void mid(Acc&, const Unit&, int, int, int, int) const {}
    __device__ __forceinline__ void operator()(const Acc& acc, const Unit& u, int wr, int wc, int fr, int fq) const {
#pragma unroll
        for (int ai = 0; ai < 2; ++ai)
#pragma unroll
            for (int m = 0; m < 4; ++m) {
                const int row = u.pm * BM + ai * HALF + wr * 64 + m * 16 + fr; float sq = 0.f;
#pragma unroll
                for (int bj = 0; bj < 2; ++bj) {
                    const size_t off = (size_t)row * 1024 + u.pn * BM + bj * HALF + wc * 32 + 8 * fq;
                    const f32x4 xa = *(const f32x4*)(x + off), xb = *(const f32x4*)(x + off + 4);
                    const f32x4 v0 = acc[ai][bj][m][0] + xa, v1 = acc[ai][bj][m][1] + xb;
                    *(f32x4*)(x1 + off) = v0; *(f32x4*)(x1 + off + 4) = v1;
                    sq += sum8sq(v0, v1);
                    *(u32x4*)(x1b + off) = pack8(v0, v1);
                }
                sq = red_fq(sq); if (fq == 0) ssq1[(size_t)row * 16 + u.pn * 4 + wc] = sq;
            }
    }
};
struct EpiE {
    static constexpr bool PERM = true, HAS_MID = false;
    bf16_t* e; float* ssqe;
    __device__ __forceinline__ void mid(Acc&, const Unit&, int, int, int, int) const {}
    __device__ __forceinline__ void operator()(const Acc& acc, const Unit& u, int wr, int wc, int fr, int fq) const {
#pragma unroll
        for (int ai = 0; ai < 2; ++ai)
#pragma unroll
            for (int m = 0; m < 4; ++m) {
                const int row = u.pm * BM + ai * HALF + wr * 64 + m * 16 + fr; float sq = 0.f;
#pragma unroll
                for (int bj = 0; bj < 2; ++bj) {
                    const size_t off = (size_t)row * 1024 + u.pn * BM + bj * HALF + wc * 32 + 8 * fq;
                    const f32x4 v0 = acc[ai][bj][m][0], v1 = acc[ai][bj][m][1];
                    sq += sum8sq(v0, v1);
                    *(u32x4*)(e + off) = pack8(v0, v1);
                }
                sq = red_fq(sq); if (fq == 0) ssqe[(size_t)row * 16 + u.pn * 4 + wc] = sq;
            }
    }
};
struct EpiG {
    static constexpr bool PERM = true, HAS_MID = false;
    const float* ssq1; const float* ssqe; const bf16_t* e; const float* gple; float* xio; float* ssq2;
    __device__ __forceinline__ void mid(Acc&, const Unit&, int, int, int, int) const {}
    __device__ __forceinline__ float row16(const float* p) const {
        const f32x4* sp = (const f32x4*)p; const f32x4 a = sp[0], b = sp[1], c = sp[2], d = sp[3];
        return (((a[0] + a[1]) + (a[2] + a[3])) + ((b[0] + b[1]) + (b[2] + b[3]))) + (((c[0] + c[1]) + (c[2] + c[3])) + ((d[0] + d[1]) + (d[2] + d[3])));
    }
    __device__ __forceinline__ void operator()(const Acc& acc, const Unit& u, int wr, int wc, int fr, int fq) const {
#pragma unroll
        for (int ai = 0; ai < 2; ++ai)
#pragma unroll
            for (int m = 0; m < 4; ++m) {
                const int row = u.pm * BM + ai * HALF + wr * 64 + m * 16 + fr; float sq = 0.f;
                const float rs1 = rsq(row16(ssq1 + (size_t)row * 16) * (1.f / 1024.f) + EPS), rse = rsq(row16(ssqe + (size_t)row * 16) * (1.f / 1024.f) + EPS);
#pragma unroll
                for (int bj = 0; bj < 2; ++bj) {
                    const int col = u.pn * BM + bj * HALF + wc * 32 + 8 * fq; const size_t off = (size_t)row * 1024 + col;
                    const f32x4 xa = *(const f32x4*)(xio + off), xb = *(const f32x4*)(xio + off + 4);
                    const f32x4 ga = *(const f32x4*)(gple + col), gb = *(const f32x4*)(gple + col + 4);
                    const u32x4 ew = *(const u32x4*)(e + off);
                    const float ev[8] = {bflo(ew[0]), bfhi(ew[0]), bflo(ew[1]), bfhi(ew[1]), bflo(ew[2]), bfhi(ew[2]), bflo(ew[3]), bfhi(ew[3])};
                    f32x4 v0, v1;
#pragma unroll
                    for (int k = 0; k < 4; ++k) {
                        v0[k] = xa[k] + sigm(acc[ai][bj][m][0][k] * rs1) * (ev[k] * rse * ga[k]);
                        v1[k] = xb[k] + sigm(acc[ai][bj][m][1][k] * rs1) * (ev[4 + k] * rse * gb[k]);
                    }
                    *(f32x4*)(xio + off) = v0; *(f32x4*)(xio + off + 4) = v1;
                    sq += sum8sq(v0, v1);
                }
                sq = red_fq(sq); if (fq == 0) ssq2[(size_t)row * 16 + u.pn * 4 + wc] = sq;
            }
    }
};

template <class Epi, class Sched, bool ALIGN_EPI = false, bool SP2 = false>
__device__ __forceinline__ void gemm_phase(LAS unsigned char* lds, const Gemm g, const Sched& S, const Epi& E) {
    int tid_ = threadIdx.x; asm volatile("" : "+v"(tid_));
    const int tid = tid_, wid = __builtin_amdgcn_readfirstlane(tid >> 6), lane = tid & 63, wr = wid >> 2, wc = wid & 3, fr = lane & 15, fq = lane >> 4;
    const int K = g.K, nt = K / BK, lda = g.lda;
    unsigned voffA[2], voffB[2];
#pragma unroll
    for (int i = 0; i < 2; ++i) { int R, C; stage_rc(tid * 16 + i * 8192, R, C); const int Rb = Epi::PERM ? ((R & ~31) + perm32(R & 31)) : R;
        voffA[i] = (unsigned)(R * lda + C) * 2u; voffB[i] = (unsigned)(Rb * K + C) * 2u; }
    const size_t kstep = (size_t)(BK * 2);
    const size_t hstepA = (size_t)HALF * lda * 2, hstepB = (size_t)HALF * K * 2;
    const size_t tstepA = 2 * hstepA, tstepB = 2 * hstepB;
    const unsigned ldsw = (unsigned)wid * 1024u;
    const int aoff = lds_byte(wr * 64 + fr, fq * 8), boff = lds_byte(wc * 32 + fr, fq * 8);
#define PG8_SA(b, h) (((b) * 2 + (h)) * HTB)
#define PG8_SB(b, h) ((4 + (b) * 2 + (h)) * HTB)
#define PG8_STAGE(bufoff, gbase, voff) do { _Pragma("unroll") for (int _i = 0; _i < 2; ++_i) \
        __builtin_amdgcn_global_load_lds((const unsigned*)((const char*)(gbase) + (voff)[_i]), (LAS unsigned*)(lds + (bufoff) + ldsw + _i * 8192), 16, 0, 0); } while (0)
#define PG8_LDA(dst, b, h) do { _Pragma("unroll") for (int m = 0; m < 4; ++m) _Pragma("unroll") for (int k = 0; k < 2; ++k) dst[m][k] = *(const LAS bf16x8*)(lds + PG8_SA(b, h) + aoff + m * 2048 + k * 1024); } while (0)
#define PG8_LDB(dst, b, h) do { _Pragma("unroll") for (int n = 0; n < 2; ++n) _Pragma("unroll") for (int k = 0; k < 2; ++k) dst[n][k] = *(const LAS bf16x8*)(lds + PG8_SB(b, h) + boff + n * 2048 + k * 1024); } while (0)
#define PG8_MMA(ai, bj, At, Bt) do { __builtin_amdgcn_s_setprio(1); _Pragma("unroll") for (int m = 0; m < 4; ++m) _Pragma("unroll") for (int n = 0; n < 2; ++n) _Pragma("unroll") for (int k = 0; k < 2; ++k) \
        acc[ai][bj][m][n] = __builtin_amdgcn_mfma_f32_16x16x32_bf16(Bt[n][k], At[m][k], acc[ai][bj][m][n], 0, 0, 0); __builtin_amdgcn_s_setprio(0); } while (0)
#define PG8_WAIT_V(n) asm volatile("s_waitcnt vmcnt(" #n ")" ::: "memory")
#define PG8_WAIT_L(n) asm volatile("s_waitcnt lgkmcnt(" #n ")" ::: "memory")
#define PG8_BAR __builtin_amdgcn_s_barrier()
#define PG8_SCHED __builtin_amdgcn_sched_barrier(0)
    Unit cur, nxt; int ui = 0;
    if (!S.next(0, cur)) return;
    Acc acc;
#pragma unroll
    for (int a = 0; a < 2; ++a)
#pragma unroll
        for (int b = 0; b < 2; ++b)
#pragma unroll
            for (int m = 0; m < 4; ++m)
#pragma unroll
                for (int n = 0; n < 2; ++n) acc[a][b][m][n] = (f32x4){0.f, 0.f, 0.f, 0.f};
    bf16x8 At[4][2], B0[2][2], B1[2][2];
    const char* cA = (const char*)g.A + (size_t)cur.pm * tstepA; const char* cB = (const char*)g.Bt + (size_t)cur.pn * tstepB;
    if constexpr (SP2) {
        PG8_STAGE(PG8_SB(0, 0), cB, voffB); PG8_STAGE(PG8_SB(0, 1), cB + hstepB, voffB); PG8_STAGE(PG8_SA(0, 0), cA, voffA); PG8_STAGE(PG8_SA(0, 1), cA + hstepA, voffA);
        if (wr == 1) PG8_BAR;
        PG8_WAIT_V(2); PG8_BAR;
        PG8_STAGE(PG8_SB(1, 0), cB + kstep, voffB); PG8_STAGE(PG8_SA(1, 0), cA + kstep, voffA); PG8_STAGE(PG8_SB(1, 1), cB + hstepB + kstep, voffB);
        PG8_WAIT_V(6); PG8_BAR;
    } else {
        PG8_STAGE(PG8_SB(0, 0), cB, voffB); PG8_STAGE(PG8_SA(0, 0), cA, voffA); PG8_STAGE(PG8_SB(0, 1), cB + hstepB, voffB); PG8_STAGE(PG8_SA(0, 1), cA + hstepA, voffA);
        if (wr == 1) PG8_BAR;
        PG8_WAIT_V(4); PG8_BAR;
        PG8_STAGE(PG8_SB(1, 0), cB + kstep, voffB); PG8_STAGE(PG8_SA(1, 0), cA + kstep, voffA); PG8_STAGE(PG8_SB(1, 1), cB + hstepB + kstep, voffB);
        PG8_WAIT_V(6); PG8_BAR;
    }
    for (;;) {
        const bool has_next = S.next(ui + 1, nxt);
        const char* nA = has_next ? (const char*)g.A + (size_t)nxt.pm * tstepA : cA; const char* nB = has_next ? (const char*)g.Bt + (size_t)nxt.pn * tstepB : cB;
        auto kloop = [&](const int t0, const int t1) __attribute__((always_inline)) {
        for (int t = t0; t < t1; t += 2) {
            const bool last = (t == nt - 2);
            const char* a1 = cA + (size_t)(t + 1) * kstep;
            const char* a2 = last ? nA : cA + (size_t)(t + 2) * kstep; const char* b2 = last ? nB : cB + (size_t)(t + 2) * kstep;
            const char* a3 = a2 + kstep; const char* b3 = b2 + kstep;
            if constexpr (SP2) {
            PG8_LDB(B0, 0, 0); PG8_LDB(B1, 0, 1); PG8_SCHED; PG8_LDA(At, 0, 0); PG8_STAGE(PG8_SA(1, 1), a1 + hstepA, voffA);
            PG8_WAIT_V(8); PG8_WAIT_L(0); PG8_BAR; PG8_MMA(0, 0, At, B0); PG8_MMA(0, 1, At, B1); PG8_BAR; PG8_SCHED;
            PG8_LDA(At, 0, 1); PG8_STAGE(PG8_SB(0, 0), b2, voffB); PG8_STAGE(PG8_SB(0, 1), b2 + hstepB, voffB); PG8_STAGE(PG8_SA(0, 0), a2, voffA);
            PG8_WAIT_V(8); PG8_WAIT_L(0); PG8_BAR; PG8_MMA(1, 0, At, B0); PG8_MMA(1, 1, At, B1); PG8_BAR; PG8_SCHED;
            PG8_LDB(B0, 1, 0); PG8_LDB(B1, 1, 1); PG8_SCHED; PG8_LDA(At, 1, 0); PG8_STAGE(PG8_SA(0, 1), a2 + hstepA, voffA);
            PG8_WAIT_V(8); PG8_WAIT_L(0); PG8_BAR; PG8_MMA(0, 0, At, B0); PG8_MMA(0, 1, At, B1); PG8_BAR; PG8_SCHED;
            PG8_LDA(At, 1, 1); PG8_STAGE(PG8_SB(1, 0), b3, voffB); PG8_STAGE(PG8_SB(1, 1), b3 + hstepB, voffB); PG8_STAGE(PG8_SA(1, 0), a3, voffA);
            PG8_WAIT_V(8); PG8_WAIT_L(0); PG8_BAR; PG8_MMA(1, 0, At, B0); PG8_MMA(1, 1, At, B1); PG8_BAR; PG8_SCHED;
            } else {
            PG8_LDB(B0, 0, 0); PG8_SCHED; PG8_LDA(At, 0, 0); PG8_STAGE(PG8_SA(1, 1), a1 + hstepA, voffA);
            PG8_WAIT_L(8); PG8_BAR; PG8_WAIT_L(0); PG8_MMA(0, 0, At, B0); PG8_BAR; PG8_SCHED;
            PG8_LDB(B1, 0, 1); PG8_STAGE(PG8_SB(0, 0), b2, voffB);
            PG8_BAR; PG8_WAIT_L(0); PG8_MMA(0, 1, At, B1); PG8_BAR;
            PG8_LDA(At, 0, 1); PG8_STAGE(PG8_SA(0, 0), a2, voffA);
            PG8_BAR; PG8_WAIT_L(0); PG8_MMA(1, 0, At, B0); PG8_BAR; PG8_SCHED;
            PG8_STAGE(PG8_SB(0, 1), b2 + hstepB, voffB);
            PG8_WAIT_V(6); PG8_BAR; PG8_MMA(1, 1, At, B1); PG8_BAR;
            PG8_LDB(B0, 1, 0); PG8_SCHED; PG8_LDA(At, 1, 0); PG8_STAGE(PG8_SA(0, 1), a2 + hstepA, voffA);
            PG8_WAIT_L(8); PG8_BAR; PG8_WAIT_L(0); PG8_MMA(0, 0, At, B0); PG8_BAR; PG8_SCHED;
            PG8_LDB(B1, 1, 1); PG8_STAGE(PG8_SB(1, 0), b3, voffB);
            PG8_BAR; PG8_WAIT_L(0); PG8_MMA(0, 1, At, B1); PG8_BAR;
            PG8_LDA(At, 1, 1); PG8_STAGE(PG8_SA(1, 0), a3, voffA);
            PG8_BAR; PG8_WAIT_L(0); PG8_MMA(1, 0, At, B0); PG8_BAR; PG8_SCHED;
            PG8_STAGE(PG8_SB(1, 1), b3 + hstepB, voffB);
            PG8_WAIT_V(6); PG8_BAR; PG8_MMA(1, 1, At, B1); PG8_BAR;
            }
        }
        };
        if constexpr (Epi::HAS_MID) { kloop(0, nt >> 1); E.mid(acc, cur, wr, wc, fr, fq); kloop(nt >> 1, nt); }
        else kloop(0, nt);
        if constexpr (ALIGN_EPI) { if (wr == 0) PG8_BAR; }
        E(acc, cur, wr, wc, fr, fq);
        if (!has_next) break;
#pragma unroll
        for (int a = 0; a < 2; ++a)
#pragma unroll
            for (int b = 0; b < 2; ++b)
#pragma unroll
                for (int m = 0; m < 4; ++m)
#pragma unroll
                    for (int n = 0; n < 2; ++n) acc[a][b][m][n] = (f32x4){0.f, 0.f, 0.f, 0.f};
        cur = nxt; cA = nA; cB = nB; ++ui;
        if constexpr (ALIGN_EPI) { if (wr == 1) PG8_BAR; }
    }
    PG8_WAIT_V(0);
    if constexpr (!ALIGN_EPI) { if (wr == 0) PG8_BAR; }
    PG8_BAR;
#undef PG8_SA
#undef PG8_SB
#undef PG8_STAGE
#undef PG8_LDA
#undef PG8_LDB
#undef PG8_MMA
#undef PG8_WAIT_V
#undef PG8_WAIT_L
#undef PG8_BAR
#undef PG8_SCHED
}
}

namespace att {
constexpr int KSL = 12288, VSL = 8192;
constexpr int L_K = 0, L_V = 2 * KSL, L_WS = L_V + 2 * VSL, L_OST = L_WS + 8 * 256, L_END = L_OST + 8 * 4096;
constexpr float THR = 8.f;
__device__ __forceinline__ int crow(int r, int hi) { return (r & 3) + 8 * (r >> 2) + 4 * hi; }
typedef short v4i16_t __attribute__((ext_vector_type(4)));
__device__ __forceinline__ s16x4 vtr(const LAS unsigned char* p) { return __builtin_bit_cast(s16x4, __builtin_amdgcn_ds_read_tr16_b64_v4i16((LAS v4i16_t*)p)); }
#define MX3(a, b, c) __builtin_fmaxf(__builtin_fmaxf((a), (b)), (c))
__device__ __forceinline__ float rowmax(const f32x16& p0, const f32x16& p1) {
    float a = MX3(p0[0], p0[1], p1[0]), b = MX3(p0[2], p0[3], p1[1]); a = MX3(a, p1[2], p1[3]);
#pragma unroll
    for (int r = 4; r < 16; r += 4) { a = MX3(a, p0[r], p0[r + 1]); b = MX3(b, p0[r + 2], p0[r + 3]); a = MX3(a, p1[r], p1[r + 1]); b = MX3(b, p1[r + 2], p1[r + 3]); }
    float m = __builtin_fmaxf(a, b); auto rr = __builtin_amdgcn_permlane32_swap(__float_as_uint(m), __float_as_uint(m), false, false);
    return __builtin_fmaxf(__uint_as_float(rr[0]), __uint_as_float(rr[1]));
}
#undef MX3
__device__ __forceinline__ void cmask(f32x16& p0, f32x16& p1, int jb, int qrel, int hi) {
    const int kb = 64 * jb + 4 * hi;
#pragma unroll
    for (int r = 0; r < 16; ++r) { const int kv = kb + (r & 3) + 8 * (r >> 2); if (kv > qrel) p0[r] = -INFINITY; if (kv + 32 > qrel) p1[r] = -INFINITY; }
}
__device__ __forceinline__ void glds(const void* g, LAS unsigned char* l) { __builtin_amdgcn_global_load_lds((const unsigned*)g, (LAS unsigned*)l, 16, 0, 0); }

__device__ __forceinline__ void attn_unit(int b, int h, int qb, const bf16_t* Q, const bf16_t* KV, const bf16_t* KR, bf16_t* ACAT, LAS unsigned char* lds) {
    const int tid = threadIdx.x, lane = tid & 63, r32 = lane & 31, hi = lane >> 5; const int wid = __builtin_amdgcn_readfirstlane(tid >> 6);
    const size_t rowbase = (size_t)b * SEQ; const int q0 = qb * 256, NT = 4 * qb + 4;
    const bf16_t* Qw = Q + (rowbase + q0 + wid * 32 + r32) * 768 + h * 96 + hi * 8;
    bf16x8 qr[6];
#pragma unroll
    for (int d0 = 0; d0 < 6; ++d0) qr[d0] = *(const bf16x8*)(Qw + d0 * 16);
    const bf16_t* ksrc = KV + (rowbase + lane) * 1024 + h * 128 + wid * 8;
    const bf16_t* rsrc = KR + (rowbase + lane) * 128 + (wid & 3) * 8;
    const bf16_t* vsrc = KV + (rowbase + 16 * (wid & 3) + (lane >> 2)) * 1024 + h * 128 + 64 + (wid >> 2) * 32 + (lane & 3) * 8;
#define ATT_DMA(t, buf) do { glds(ksrc + (size_t)(t) * 64 * 1024, lds + L_K + (buf) * KSL + wid * 1024); \
        if (wid < 4) glds(rsrc + (size_t)(t) * 64 * 128, lds + L_K + (buf) * KSL + (8 + wid) * 1024); \
        glds(vsrc + (size_t)(t) * 64 * 1024, lds + L_V + (buf) * VSL + wid * 1024); } while (0)
    LAS float* wsf = (LAS float*)(lds + L_WS) + wid * 64;
    const int qrel = wid * 32 + r32;
    float mhat = 0.f, l_reg = 0.f; f32x16 o0 = {}, o1 = {};
    ATT_DMA(0, 0);
    for (int t = 0; t < NT; ++t) {
        asm volatile("s_waitcnt vmcnt(0)" ::: "memory");
        __syncthreads();
        if (t + 1 < NT) ATT_DMA(t + 1, (t + 1) & 1);
        const int buf = t & 1;
        const LAS unsigned char* kp = lds + L_K + buf * KSL + hi * 1024 + r32 * 16;
        f32x16 p0 = {}, p1 = {};
#pragma unroll
        for (int d0 = 0; d0 < 6; ++d0) {
            const bf16x8 b0 = *(const LAS bf16x8*)(kp + d0 * 2048), b1 = *(const LAS bf16x8*)(kp + d0 * 2048 + 512);
            p0 = __builtin_amdgcn_mfma_f32_32x32x16_bf16(b0, qr[d0], p0, 0, 0, 0);
            p1 = __builtin_amdgcn_mfma_f32_32x32x16_bf16(b1, qr[d0], p1, 0, 0, 0);
        }
        if (t >= NT - 4) cmask(p0, p1, t - (NT - 4), qrel, hi);
        const float rm = rowmax(p0, p1);
        if (t == 0) mhat = rm;
        else if (__any(rm > mhat + THR)) {
            const float mn = __builtin_fmaxf(mhat, rm), f = __builtin_amdgcn_exp2f(mhat - mn);
            l_reg *= f; mhat = mn;
            if (hi == 0) wsf[r32] = f;
            asm volatile("s_waitcnt lgkmcnt(0)" ::: "memory");
#pragma unroll
            for (int r = 0; r < 16; ++r) { const float fr_ = wsf[crow(r, hi)]; o0[r] *= fr_; o1[r] *= fr_; }
        }
        float sacc = 0.f;
#pragma unroll
        for (int r = 0; r < 16; ++r) { p0[r] = __builtin_amdgcn_exp2f(p0[r] - mhat); p1[r] = __builtin_amdgcn_exp2f(p1[r] - mhat); sacc += p0[r] + p1[r]; }
        l_reg += sacc;
        u32x4 pw[4];
#pragma unroll
        for (int j = 0; j < 4; ++j) { pw[0][j] = cvt_pk_bf16(p0[2 * j], p0[2 * j + 1]); pw[1][j] = cvt_pk_bf16(p0[8 + 2 * j], p0[8 + 2 * j + 1]);
                                      pw[2][j] = cvt_pk_bf16(p1[2 * j], p1[2 * j + 1]); pw[3][j] = cvt_pk_bf16(p1[8 + 2 * j], p1[8 + 2 * j + 1]); }
        const LAS unsigned char* vp = lds + L_V + buf * VSL + ((lane >> 4) & 1) * 32 + (lane & 3) * 8 + (4 * hi + ((lane & 15) >> 2)) * 64;
#pragma unroll
        for (int ks = 0; ks < 4; ++ks) {
            const s16x4 lo0 = vtr(vp + ks * 1024), hi0 = vtr(vp + ks * 1024 + 512), lo1 = vtr(vp + 4096 + ks * 1024), hi1 = vtr(vp + 4096 + ks * 1024 + 512);
            const bf16x8 v0 = (bf16x8){lo0[0], lo0[1], lo0[2], lo0[3], hi0[0], hi0[1], hi0[2], hi0[3]}, v1 = (bf16x8){lo1[0], lo1[1], lo1[2], lo1[3], hi1[0], hi1[1], hi1[2], hi1[3]};
            const bf16x8 pa = __builtin_bit_cast(bf16x8, pw[ks]);
            o0 = __builtin_amdgcn_mfma_f32_32x32x16_bf16(pa, v0, o0, 0, 0, 0);
            o1 = __builtin_amdgcn_mfma_f32_32x32x16_bf16(pa, v1, o1, 0, 0, 0);
        }
    }
#undef ATT_DMA
    { auto rr = __builtin_amdgcn_permlane32_swap(__float_as_uint(l_reg), __float_as_uint(l_reg), false, false); l_reg = __uint_as_float(rr[0]) + __uint_as_float(rr[1]); }
    if (hi == 0) wsf[32 + r32] = l_reg;
    asm volatile("s_waitcnt lgkmcnt(0)" ::: "memory");
    LAS bf16_t* stg = (LAS bf16_t*)(lds + L_OST) + wid * 2048;
#pragma unroll
    for (int r = 0; r < 16; ++r) { const int orow = crow(r, hi); const float rl = __builtin_amdgcn_rcpf(wsf[32 + orow]);
        stg[orow * 64 + r32] = (bf16_t)(cvt_pk_bf16(o0[r] * rl, 0.f) & 0xffffu); stg[orow * 64 + 32 + r32] = (bf16_t)(cvt_pk_bf16(o1[r] * rl, 0.f) & 0xffffu); }
    asm volatile("s_waitcnt lgkmcnt(0)" ::: "memory");
    bf16_t* Ow = ACAT + (rowbase + q0 + wid * 32) * 1024 + h * 64;
#pragma unroll
    for (int i = 0; i < 4; ++i) { const int row = i * 8 + (lane >> 3), ch = lane & 7;
        const u32x4 v = *(const LAS u32x4*)(stg + row * 64 + ch * 8); bf16_t* gp = Ow + (size_t)row * 1024 + ch * 8; const u32x4 gt = *(const u32x4*)gp; u32x4 w;
#pragma unroll
        for (int e = 0; e < 4; ++e) w[e] = cvt_pk_bf16(bflo(v[e]) * bflo(gt[e]), bfhi(v[e]) * bfhi(gt[e]));
        *(u32x4*)gp = w; }
    asm volatile("s_waitcnt lgkmcnt(0)" ::: "memory");
    __syncthreads();
}
}

namespace gla {
constexpr int P = 144;
constexpr int L_QD = 0, L_KD = 9216, L_KDT = 18432, L_VT = 27648, L_ATT = 46080, L_TOT = 55296, L_EB = 57344, L_SSQ = 57600, L_GKL = 59648, L_END = 63744;
__device__ __forceinline__ f32x4 mfma16(bf16x8 a, bf16x8 b, f32x4 c) { return __builtin_amdgcn_mfma_f32_16x16x32_bf16(a, b, c, 0, 0, 0); }
__device__ __forceinline__ float logsig(float x) { return __builtin_fminf(x, 0.f) - __logf(1.f + __expf(-__builtin_fabsf(x))); }

__device__ __forceinline__ void gla_item(int bh, const bf16_t* GQ, const bf16_t* GK, const bf16_t* GV, const bf16_t* SMALL, const float* w_up, const float* b_gk, const float* gnorm, bf16_t* ACAT, LAS unsigned char* lds) {
    const int tid = threadIdx.x, lane = tid & 63, l15 = lane & 15, kg = lane >> 4; const int w = __builtin_amdgcn_readfirstlane(tid >> 6);
    const int b = bh >> 2, h = bh & 3;
    float wup[16];
#pragma unroll
    for (int r = 0; r < 16; ++r) wup[r] = w_up[r * 256 + h * 64 + lane];
    const float bias = b_gk[h * 64 + lane], gn = gnorm[16 * w + l15];
    LAS float* TOT = (LAS float*)(lds + L_TOT); LAS float* EB = (LAS float*)(lds + L_EB); LAS float* SSQ = (LAS float*)(lds + L_SSQ); LAS float* GKL = (LAS float*)(lds + L_GKL);
    f32x4 S[4];
#pragma unroll
    for (int i = 0; i < 4; ++i) S[i] = (f32x4){0.f, 0.f, 0.f, 0.f};
    const int vc = tid & 127, tg2 = tid >> 7;
    for (int n = 0; n < 32; ++n) {
        const size_t row0 = (size_t)b * SEQ + (size_t)n * 64;
        { const int tok = tid >> 3, pr = tid & 7; const unsigned g2 = *(const unsigned*)(SMALL + (row0 + tok) * 128 + 32 + 2 * pr); GKL[tok * 16 + 2 * pr] = bflo(g2); GKL[tok * 16 + 2 * pr + 1] = bfhi(g2); }
        bf16_t qv[8], kv[8], vv[16];
        { const GAS bf16_t* qp = (const GAS bf16_t*)(GQ + (row0 + 8 * w) * 256 + h * 64 + lane); const GAS bf16_t* kp = (const GAS bf16_t*)(GK + (row0 + 8 * w) * 256 + h * 64 + lane); const GAS bf16_t* vp = (const GAS bf16_t*)(GV + (row0 + 16 * tg2) * 512 + h * 128 + vc);
          asm volatile("" : "+v"(qp), "+v"(kp), "+v"(vp));
#pragma unroll
          for (int e = 0; e < 8; ++e) { qv[e] = qp[e * 256]; kv[e] = kp[e * 256]; }
#pragma unroll
          for (int e = 0; e < 16; ++e) vv[e] = vp[e * 512]; }
        __syncthreads();
        float c8[8]; float run = 0.f;
#pragma unroll
        for (int e = 0; e < 8; ++e) {
            const LAS f32x4* gp = (const LAS f32x4*)(GKL + (8 * w + e) * 16); float x = bias;
#pragma unroll
            for (int r4 = 0; r4 < 4; ++r4) { const f32x4 gq4 = gp[r4]; x += gq4[0] * wup[4 * r4] + gq4[1] * wup[4 * r4 + 1] + gq4[2] * wup[4 * r4 + 2] + gq4[3] * wup[4 * r4 + 3]; }
            run += logsig(x) * (1.f / 16.f); c8[e] = run;
        }
        TOT[w * 64 + lane] = run;
        __syncthreads();
        float prefix = 0.f, total = 0.f;
#pragma unroll
        for (int ww = 0; ww < 8; ++ww) { const float tv = TOT[ww * 64 + lane]; total += tv; if (ww < w) prefix += tv; }
        {
            float kd8[8];
#pragma unroll
            for (int e = 0; e < 8; ++e) {
                const float bc = prefix + c8[e], eq = __expf(bc), ek = __expf(-bc), ed = __expf(total - bc);
                const float qf = bf1(qv[e]) * 0.125f * eq, kf = bf1(kv[e]);
                *(LAS bf16_t*)(lds + L_QD + (8 * w + e) * P + lane * 2) = (bf16_t)(cvt_pk_bf16(qf, 0.f) & 0xffffu);
                *(LAS bf16_t*)(lds + L_KD + (8 * w + e) * P + lane * 2) = (bf16_t)(cvt_pk_bf16(kf * ek, 0.f) & 0xffffu);
                kd8[e] = kf * ed;
            }
            u32x4 kw; kw.x = cvt_pk_bf16(kd8[0], kd8[1]); kw.y = cvt_pk_bf16(kd8[2], kd8[3]); kw.z = cvt_pk_bf16(kd8[4], kd8[5]); kw.w = cvt_pk_bf16(kd8[6], kd8[7]);
            *(LAS u32x4*)(lds + L_KDT + lane * P + 16 * w) = kw;
            if (w == 0) EB[lane] = __expf(total);
            u32x4 v0, v1;
            v0.x = (unsigned)vv[0] | ((unsigned)vv[1] << 16); v0.y = (unsigned)vv[2] | ((unsigned)vv[3] << 16); v0.z = (unsigned)vv[4] | ((unsigned)vv[5] << 16); v0.w = (unsigned)vv[6] | ((unsigned)vv[7] << 16);
            v1.x = (unsigned)vv[8] | ((unsigned)vv[9] << 16); v1.y = (unsigned)vv[10] | ((unsigned)vv[11] << 16); v1.z = (unsigned)vv[12] | ((unsigned)vv[13] << 16); v1.w = (unsigned)vv[14] | ((unsigned)vv[15] << 16);
            *(LAS u32x4*)(lds + L_VT + vc * P + 32 * tg2) = v0; *(LAS u32x4*)(lds + L_VT + vc * P + 32 * tg2 + 16) = v1;
        }
        __syncthreads();
        {
            const int mt = w >> 1;
#pragma unroll
            for (int q = 0; q < 2; ++q) {
                const int nt = 2 * (w & 1) + q; f32x4 a = (f32x4){0.f, 0.f, 0.f, 0.f};
                if (nt <= mt) {
#pragma unroll
                    for (int s = 0; s < 2; ++s) { const bf16x8 A = *(const LAS bf16x8*)(lds + L_QD + (16 * mt + l15) * P + 64 * s + 16 * kg), B = *(const LAS bf16x8*)(lds + L_KD + (16 * nt + l15) * P + 64 * s + 16 * kg); a = mfma16(A, B, a); }
                }
#pragma unroll
                for (int r = 0; r < 4; ++r) { const int i = 16 * mt + 4 * kg + r, j = 16 * nt + l15; const float v = (j <= i) ? a[r] : 0.f;
                    *(LAS bf16_t*)(lds + L_ATT + i * P + j * 2) = (bf16_t)(cvt_pk_bf16(v, 0.f) & 0xffffu); }
            }
        }
        __syncthreads();
        f32x4 o[4];
        {
            bf16x8 bv[2], bs[2];
#pragma unroll
            for (int s = 0; s < 2; ++s) { bv[s] = *(const LAS bf16x8*)(lds + L_VT + (16 * w + l15) * P + 64 * s + 16 * kg);
                u32x4 t; t.x = cvt_pk_bf16(S[2 * s][0], S[2 * s][1]); t.y = cvt_pk_bf16(S[2 * s][2], S[2 * s][3]); t.z = cvt_pk_bf16(S[2 * s + 1][0], S[2 * s + 1][1]); t.w = cvt_pk_bf16(S[2 * s + 1][2], S[2 * s + 1][3]); bs[s] = __builtin_bit_cast(bf16x8, t); }
#pragma unroll
            for (int mt = 0; mt < 4; ++mt) {
                f32x4 a = (f32x4){0.f, 0.f, 0.f, 0.f};
#pragma unroll
                for (int s = 0; s < 2; ++s) { const u32x2 lo = *(const LAS u32x2*)(lds + L_QD + (16 * mt + l15) * P + 64 * s + 8 * kg), hi2 = *(const LAS u32x2*)(lds + L_QD + (16 * mt + l15) * P + 64 * s + 32 + 8 * kg);
                    u32x4 t; t.x = lo.x; t.y = lo.y; t.z = hi2.x; t.w = hi2.y; a = mfma16(__builtin_bit_cast(bf16x8, t), bs[s], a); }
#pragma unroll
                for (int s = 0; s < 2; ++s) { const bf16x8 A = *(const LAS bf16x8*)(lds + L_ATT + (16 * mt + l15) * P + 64 * s + 16 * kg); a = mfma16(A, bv[s], a); }
                o[mt] = a;
            }
#pragma unroll
            for (int mt = 0; mt < 4; ++mt) {
                const f32x4 eb4 = *(const LAS f32x4*)(EB + 16 * mt + 4 * kg); f32x4 a = S[mt] * eb4;
#pragma unroll
                for (int s = 0; s < 2; ++s) { const bf16x8 A = *(const LAS bf16x8*)(lds + L_KDT + (16 * mt + l15) * P + 64 * s + 16 * kg); a = mfma16(A, bv[s], a); }
                S[mt] = a;
            }
        }
#pragma unroll
        for (int mt = 0; mt < 4; ++mt)
#pragma unroll
            for (int r = 0; r < 4; ++r) { float s = o[mt][r] * o[mt][r]; s += __shfl_xor(s, 1); s += __shfl_xor(s, 2); s += __shfl_xor(s, 4); s += __shfl_xor(s, 8);
                if (l15 == 0) SSQ[(16 * mt + 4 * kg + r) * 8 + w] = s; }
        __syncthreads();
        GAS bf16_t* gbase = (GAS bf16_t*)(ACAT + (row0 + 4 * kg) * 1024 + 512 + h * 128 + 16 * w + l15); asm volatile("" : "+v"(gbase));
#pragma unroll
        for (int mt = 0; mt < 4; ++mt)
#pragma unroll
            for (int r = 0; r < 4; ++r) { const int tok = 16 * mt + 4 * kg + r; const LAS f32x4* sp = (const LAS f32x4*)(SSQ + tok * 8); const f32x4 a = sp[0], c = sp[1];
                const float tot = ((a[0] + a[1]) + (a[2] + a[3])) + ((c[0] + c[1]) + (c[2] + c[3])); const float rs = rsq(tot * (1.f / 128.f) + EPS);
                GAS bf16_t* gp = gbase + (size_t)(16 * mt + r) * 1024; const float gate = bf1(*gp);
                *gp = (bf16_t)(cvt_pk_bf16(o[mt][r] * rs * gn * gate, 0.f) & 0xffffu); }
    }
    __syncthreads();
}
}

namespace gla2 {
constexpr int WREG = 16384;
constexpr int PA = 144;
typedef short v4i16_t __attribute__((ext_vector_type(4)));
__device__ __forceinline__ s16x4 trr(const LAS unsigned char* p) { return __builtin_bit_cast(s16x4, __builtin_amdgcn_ds_read_tr16_b64_v4i16((LAS v4i16_t*)p)); }
__device__ __forceinline__ bf16x8 cat(s16x4 a, s16x4 b) { return (bf16x8){a[0], a[1], a[2], a[3], b[0], b[1], b[2], b[3]}; }
__device__ __forceinline__ f32x4 mfma16(bf16x8 a, bf16x8 b, f32x4 c) { return __builtin_amdgcn_mfma_f32_16x16x32_bf16(a, b, c, 0, 0, 0); }

__device__ __forceinline__ void g1_wave(int c, const bf16_t* GQ, const bf16_t* GK, const bf16_t* GV, const bf16_t* SMALL, const float* w_up, const float* b_gk,
                                        bf16_t* QDT, bf16_t* KDT, float* SLOC, float* EBG, LAS unsigned char* wl, int lane) {
    const int bh = c >> 5, n = c & 31, b = bh >> 2, h = bh & 3, l15 = lane & 15, kg = lane >> 4;
    const size_t row0 = (size_t)b * SEQ + (size_t)n * 64;
    LAS unsigned char* AR = wl; LAS unsigned char* VR = wl + 9216; LAS float* GKL = (LAS float*)(wl + 9216);
    { const u32x4* sp = (const u32x4*)(SMALL + (row0 + lane) * 128 + 32); const u32x4 g0 = sp[0], g1 = sp[1];
      LAS f32x4* gp = (LAS f32x4*)(GKL + lane * 16);
      gp[0] = (f32x4){bflo(g0[0]), bfhi(g0[0]), bflo(g0[1]), bfhi(g0[1])}; gp[1] = (f32x4){bflo(g0[2]), bfhi(g0[2]), bflo(g0[3]), bfhi(g0[3])};
      gp[2] = (f32x4){bflo(g1[0]), bfhi(g1[0]), bflo(g1[1]), bfhi(g1[1])}; gp[3] = (f32x4){bflo(g1[2]), bfhi(g1[2]), bflo(g1[3]), bfhi(g1[3])}; }
    u32x4 qld[8], kld[8];
#pragma unroll
    for (int i = 0; i < 8; ++i) { const int idx = i * 64 + lane, tok = idx >> 3, d8 = idx & 7; const size_t o = (row0 + tok) * 256 + h * 64 + d8 * 8; qld[i] = *(const u32x4*)(GQ + o); kld[i] = *(const u32x4*)(GK + o); }
    float wup[16];
#pragma unroll
    for (int r = 0; r < 16; ++r) wup[r] = w_up[r * 256 + h * 64 + lane];
    const float bias = b_gk[h * 64 + lane];
    float bc[64]; float run = 0.f;
#pragma unroll
    for (int t = 0; t < 64; ++t) {
        const LAS f32x4* gp = (const LAS f32x4*)(GKL + t * 16); float x = bias;
#pragma unroll
        for (int r4 = 0; r4 < 4; ++r4) { const f32x4 g4 = gp[r4]; x += g4[0] * wup[4 * r4] + g4[1] * wup[4 * r4 + 1] + g4[2] * wup[4 * r4 + 2] + g4[3] * wup[4 * r4 + 3]; }
        const float ls2 = __builtin_fminf(x, 0.f) * LOG2E - __builtin_amdgcn_logf(1.f + __builtin_amdgcn_exp2f(-LOG2E * __builtin_fabsf(x)));
        run += ls2 * (1.f / 16.f); bc[t] = run;
    }
    const float etot = __builtin_amdgcn_exp2f(run);
#pragma unroll
    for (int i = 0; i < 8; ++i) { const int idx = i * 64 + lane, tok = idx >> 3, d8 = idx & 7; *(LAS u32x4*)(AR + tok * PA + d8 * 16) = qld[i]; }
    {
        unsigned pk[32];
#pragma unroll
        for (int t = 0; t < 64; t += 2) {
            const float q0 = bf1(*(const LAS bf16_t*)(AR + t * PA + lane * 2)), q1 = bf1(*(const LAS bf16_t*)(AR + (t + 1) * PA + lane * 2));
            pk[t >> 1] = cvt_pk_bf16(q0 * 0.125f * __builtin_amdgcn_exp2f(bc[t]), q1 * 0.125f * __builtin_amdgcn_exp2f(bc[t + 1]));
        }
        u32x4* dst = (u32x4*)(QDT + (size_t)c * 4096 + lane * 64);
#pragma unroll
        for (int i = 0; i < 8; ++i) dst[i] = (u32x4){pk[4 * i], pk[4 * i + 1], pk[4 * i + 2], pk[4 * i + 3]};
    }
#pragma unroll
    for (int i = 0; i < 8; ++i) { const int idx = i * 64 + lane, tok = idx >> 3, d8 = idx & 7; *(LAS u32x4*)(AR + tok * PA + d8 * 16) = kld[i]; }
    {
        unsigned pk[32], pd[32];
#pragma unroll
        for (int t = 0; t < 64; t += 2) {
            const float k0 = bf1(*(const LAS bf16_t*)(AR + t * PA + lane * 2)), k1 = bf1(*(const LAS bf16_t*)(AR + (t + 1) * PA + lane * 2));
            const float e0 = __builtin_amdgcn_exp2f(-bc[t]), e1 = __builtin_amdgcn_exp2f(-bc[t + 1]);
            pk[t >> 1] = cvt_pk_bf16(k0 * e0, k1 * e1); pd[t >> 1] = cvt_pk_bf16(k0 * e0 * etot, k1 * e1 * etot);
        }
        u32x4* dst = (u32x4*)(KDT + (size_t)c * 4096 + lane * 64);
#pragma unroll
        for (int i = 0; i < 8; ++i) dst[i] = (u32x4){pk[4 * i], pk[4 * i + 1], pk[4 * i + 2], pk[4 * i + 3]};
#pragma unroll
        for (int i = 0; i < 8; ++i) *(LAS u32x4*)(AR + lane * PA + i * 16) = (u32x4){pd[4 * i], pd[4 * i + 1], pd[4 * i + 2], pd[4 * i + 3]};
    }
    EBG[(size_t)c * 64 + lane] = etot;
    bf16x8 af[4][2];
#pragma unroll
    for (int mt = 0; mt < 4; ++mt)
#pragma unroll
        for (int s2 = 0; s2 < 2; ++s2) af[mt][s2] = *(const LAS bf16x8*)(AR + (16 * mt + l15) * PA + 64 * s2 + 16 * kg);
#pragma unroll 1
    for (int vs = 0; vs < 4; ++vs) {
        u32x4 vld[4];
#pragma unroll
        for (int i = 0; i < 4; ++i) { const int idx = i * 64 + lane, tok = idx >> 2, c4 = idx & 3; vld[i] = *(const u32x4*)(GV + (row0 + tok) * 512 + h * 128 + vs * 32 + c4 * 8); }
#pragma unroll
        for (int i = 0; i < 4; ++i) { const int idx = i * 64 + lane, tok = idx >> 2, c4 = idx & 3; *(LAS u32x4*)(VR + tok * 80 + c4 * 16) = vld[i]; }
#pragma unroll
        for (int nt2 = 0; nt2 < 2; ++nt2) {
            bf16x8 bv[2];
#pragma unroll
            for (int s2 = 0; s2 < 2; ++s2) { const LAS unsigned char* vp = VR + (32 * s2 + 8 * kg + (l15 >> 2)) * 80 + nt2 * 32 + (l15 & 3) * 8; bv[s2] = cat(trr(vp), trr(vp + 4 * 80)); }
            float* dst = SLOC + (((size_t)c * 8 + vs * 2 + nt2) * 64 + lane) * 16;
#pragma unroll
            for (int mt = 0; mt < 4; ++mt) { f32x4 a = (f32x4){0.f, 0.f, 0.f, 0.f}; a = mfma16(af[mt][0], bv[0], a); a = mfma16(af[mt][1], bv[1], a); *(f32x4*)(dst + mt * 4) = a; }
        }
    }
}

__device__ __forceinline__ void g2_thread(int gid, const float* SLOC, const float* EBG, bf16_t* SN) {
    const int bh = gid >> 11, rem = gid & 2047, nt = rem >> 8, ln = (rem >> 2) & 63, mt = rem & 3, dk0 = 16 * mt + 4 * (ln >> 4);
    f32x4 st = (f32x4){0.f, 0.f, 0.f, 0.f};
#pragma unroll 8
    for (int n = 0; n < 32; ++n) {
        const size_t c = (size_t)bh * 32 + n; const size_t e = ((c * 8 + nt) * 64 + ln) * 16 + mt * 4;
        u32x2 w; w.x = cvt_pk_bf16(st[0], st[1]); w.y = cvt_pk_bf16(st[2], st[3]); *(u32x2*)(SN + e) = w;
        const f32x4 sl = *(const f32x4*)(SLOC + e), eb = *(const f32x4*)(EBG + c * 64 + dk0);
        st = st * eb + sl;
    }
}

__device__ __forceinline__ void g3_wave(int c, const bf16_t* QDT, const bf16_t* KDT, const bf16_t* GV, const bf16_t* SN, const float* gnorm, bf16_t* ACAT, LAS unsigned char* wl, int lane) {
    const int bh = c >> 5, n = c & 31, b = bh >> 2, h = bh & 3, l15 = lane & 15, kg = lane >> 4;
    const size_t row0 = (size_t)b * SEQ + (size_t)n * 64;
    u32x4 ql[8], kl[8];
#pragma unroll
    for (int i = 0; i < 8; ++i) { ql[i] = *(const u32x4*)(QDT + (size_t)c * 4096 + (size_t)(i * 64 + lane) * 8); kl[i] = *(const u32x4*)(KDT + (size_t)c * 4096 + (size_t)(i * 64 + lane) * 8); }
    const int fro = (4 * kg + (l15 >> 2)) * PA + (l15 & 3) * 8;
    bf16x8 qf[4][2], kf[4][2];
#pragma unroll
    for (int i = 0; i < 8; ++i) { const int idx = i * 64 + lane, d = idx >> 3, t8 = idx & 7; *(LAS u32x4*)(wl + d * PA + t8 * 16) = ql[i]; }
#pragma unroll
    for (int it = 0; it < 4; ++it)
#pragma unroll
        for (int s2 = 0; s2 < 2; ++s2) { const LAS unsigned char* p = wl + fro + (32 * s2) * PA + it * 32; qf[it][s2] = cat(trr(p), trr(p + 16 * PA)); }
#pragma unroll
    for (int i = 0; i < 8; ++i) { const int idx = i * 64 + lane, d = idx >> 3, t8 = idx & 7; *(LAS u32x4*)(wl + d * PA + t8 * 16) = kl[i]; }
#pragma unroll
    for (int jt = 0; jt < 4; ++jt)
#pragma unroll
        for (int s2 = 0; s2 < 2; ++s2) { const LAS unsigned char* p = wl + fro + (32 * s2) * PA + jt * 32; kf[jt][s2] = cat(trr(p), trr(p + 16 * PA)); }
    u32x4 sf[8][2];
#pragma unroll
    for (int nt = 0; nt < 8; ++nt) { const u32x4* sp = (const u32x4*)(SN + (((size_t)c * 8 + nt) * 64 + lane) * 16); sf[nt][0] = sp[0]; sf[nt][1] = sp[1]; }
    u32x4 ab[4][2];
#pragma unroll
    for (int it = 0; it < 4; ++it) {
        f32x4 at[4];
#pragma unroll
        for (int jt = 0; jt < 4; ++jt) {
            at[jt] = (f32x4){0.f, 0.f, 0.f, 0.f};
            if (jt <= it) { at[jt] = mfma16(kf[jt][0], qf[it][0], at[jt]); at[jt] = mfma16(kf[jt][1], qf[it][1], at[jt]); }
            if (jt == it) {
#pragma unroll
                for (int r = 0; r < 4; ++r) if (4 * kg + r > l15) at[jt][r] = 0.f;
            }
        }
#pragma unroll
        for (int s2 = 0; s2 < 2; ++s2) { ab[it][s2].x = cvt_pk_bf16(at[2 * s2][0], at[2 * s2][1]); ab[it][s2].y = cvt_pk_bf16(at[2 * s2][2], at[2 * s2][3]); ab[it][s2].z = cvt_pk_bf16(at[2 * s2 + 1][0], at[2 * s2 + 1][1]); ab[it][s2].w = cvt_pk_bf16(at[2 * s2 + 1][2], at[2 * s2 + 1][3]); }
    }
    {
        u32x4 vl[16];
#pragma unroll
        for (int i = 0; i < 16; ++i) { const int idx = i * 64 + lane, tok = idx >> 4, c16 = idx & 15; vl[i] = *(const u32x4*)(GV + (row0 + tok) * 512 + h * 128 + c16 * 8); }
#pragma unroll
        for (int i = 0; i < 16; ++i) { const int idx = i * 64 + lane, tok = idx >> 4, c16 = idx & 15; *(LAS u32x4*)(wl + tok * 256 + ((c16 ^ ((tok & 7) << 1)) * 16)) = vl[i]; }
    }
    const int vrow = 4 * kg + (l15 >> 2), vx = vrow & 7;
    const LAS unsigned char* vbase = wl + vrow * 256 + (l15 & 3) * 8;
#pragma unroll 1
    for (int it = 0; it < 4; ++it) {
        f32x4 o[8]; float ssq = 0.f;
#pragma unroll
        for (int nt = 0; nt < 8; ++nt) {
            f32x4 a = (f32x4){0.f, 0.f, 0.f, 0.f};
            a = mfma16(__builtin_bit_cast(bf16x8, sf[nt][0]), qf[it][0], a); a = mfma16(__builtin_bit_cast(bf16x8, sf[nt][1]), qf[it][1], a);
            const LAS unsigned char* vp = vbase + ((nt ^ vx) * 32);
            { const bf16x8 v0 = cat(trr(vp), trr(vp + 16 * 256)); a = mfma16(v0, __builtin_bit_cast(bf16x8, ab[it][0]), a); }
            if (it >= 2) { const bf16x8 v1 = cat(trr(vp + 32 * 256), trr(vp + 48 * 256)); a = mfma16(v1, __builtin_bit_cast(bf16x8, ab[it][1]), a); }
            o[nt] = a; ssq += (a[0] * a[0] + a[1] * a[1]) + (a[2] * a[2] + a[3] * a[3]);
        }
        ssq += __shfl_xor(ssq, 16); ssq += __shfl_xor(ssq, 32);
        const float rs = rsq(ssq * (1.f / 128.f) + EPS);
        bf16_t* gp = ACAT + (row0 + 16 * it + l15) * 1024 + 512 + h * 128 + 4 * kg;
#pragma unroll
        for (int nt = 0; nt < 8; ++nt) {
            const f32x4 gn = *(const f32x4*)(gnorm + 16 * nt + 4 * kg); const u32x2 gt = *(const u32x2*)(gp + 16 * nt);
            u32x2 w; w.x = cvt_pk_bf16(o[nt][0] * rs * gn[0] * bflo(gt.x), o[nt][1] * rs * gn[1] * bfhi(gt.x)); w.y = cvt_pk_bf16(o[nt][2] * rs * gn[2] * bflo(gt.y), o[nt][3] * rs * gn[3] * bfhi(gt.y));
            *(u32x2*)(gp + 16 * nt) = w;
        }
    }
}
}

constexpr int NWAVES = 8;
#ifndef PROBE_DUP
#define PROBE_DUP 0
#endif
#ifndef PHMASK
#define PHMASK 0x7ff
#endif
constexpr size_t MiB = 1u << 20;
constexpr size_t WS_CTL = 0, CTL_ZERO_BYTES = 1 * MiB;
constexpr size_t WS_WIN = 2 * MiB, WS_WUQ = 12 * MiB, WS_WUKV = 13 * MiB, WS_WCAT = 14 * MiB, WS_WOUT = 16 * MiB, WS_WPLE = 18 * MiB, WS_WPLEG = 19 * MiB;
constexpr size_t WS_ROPE = 22 * MiB, WS_SSQA = 26 * MiB, WS_SSQ1 = 30 * MiB, WS_SSQE = 32 * MiB, WS_SSQ2 = 34 * MiB;
constexpr size_t WS_PB = 36 * MiB, WS_ACAT = 52 * MiB, WS_SMA = 116 * MiB, WS_SMB = 180 * MiB;
constexpr size_t WS_S1 = 244 * MiB;
constexpr size_t WS_S2 = 308 * MiB;
constexpr size_t WS_S3 = 372 * MiB;
constexpr size_t WS_Q = 444 * MiB, WS_END = 492 * MiB;
constexpr size_t WS_H = WS_S1, WS_KV = WS_S1, WS_MERGED = WS_S1;
constexpr size_t WS_CQ = WS_S2, WS_CKV = WS_S2 + 24 * MiB, WS_X1B = WS_S2;
constexpr size_t WS_GQ = WS_S3, WS_GK = WS_S3 + 16 * MiB, WS_GV = WS_S3 + 32 * MiB, WS_SMALL = WS_S3 + 64 * MiB, WS_E = WS_S3;
constexpr int CW_BAR = 4096;
constexpr int CW_Q = 16384;
constexpr int RING_OFF = 0, RING_BYTES = 131072;
constexpr int LDSCTL_OFF = RING_BYTES, MISC_OFF = LDSCTL_OFF + 320;
constexpr int LDS_BYTES = 147456;
static_assert(att::L_END <= RING_BYTES && gla::L_END <= RING_BYTES && MISC_OFF + 128 <= LDS_BYTES, "LDS map");

typedef GAS unsigned gu32;
#define RLX_AGENT __ATOMIC_RELAXED, __HIP_MEMORY_SCOPE_AGENT
#define LDS_WAIT() asm volatile("s_waitcnt lgkmcnt(0)" ::: "memory")
#define VM_WAIT() asm volatile("s_waitcnt vmcnt(0)" ::: "memory")

#define XB_TMO      128
#define XB_XCNT(j)  (256  + 64 * (j))
#define XB_XSUB(j)  (1280 + 64 * (j))
#define XB_XGEN(j)  (2304 + 64 * (j))
#define XB_TOP      3328
#define XB_TOPGEN   3392
#define XCD_BAR_WORDS 3456
#define XB_SPIN_CAP (1u << 18)
__device__ __forceinline__ unsigned xb_ld(unsigned* p)              { return __hip_atomic_load(p, __ATOMIC_RELAXED, __HIP_MEMORY_SCOPE_AGENT); }
__device__ __forceinline__ unsigned xb_add(unsigned* p, unsigned v) { return __hip_atomic_fetch_add(p, v, __ATOMIC_RELAXED, __HIP_MEMORY_SCOPE_AGENT); }
__device__ __forceinline__ unsigned xb_xcc_id() { return (unsigned)__builtin_amdgcn_s_getreg((3 << 11) | 20) & 0xFu; }
#define XB_SPIN(cond, bar) do { unsigned _sp = 0; while (cond) { __builtin_amdgcn_s_sleep(1); \
    if ((++_sp & 255u) == 0u) { if (xb_ld(&(bar)[XB_TMO])) break; if (_sp > XB_SPIN_CAP) { atomicAdd(&(bar)[XB_TMO], 1u); break; } } } } while (0)
struct XcdBarrier { unsigned* bar; unsigned x; volatile LAS unsigned* st; };
__device__ __forceinline__ XcdBarrier xcd_barrier_post(unsigned* bar, volatile LAS unsigned* st) {
    XcdBarrier b; b.bar = bar; b.x = xb_xcc_id(); b.st = st;
    if (threadIdx.x == 0) (void)xb_add(&bar[XB_XCNT(b.x)], 1u);
    return b;
}
__device__ __forceinline__ void xcd_barrier_complete(unsigned* bar, unsigned x, unsigned& nloc, unsigned& nx) {
    const unsigned G = gridDim.x * gridDim.y * gridDim.z;
    unsigned sum, cnt, mine, sp = 0u;
    for (;;) {
        sum = 0u; cnt = 0u; mine = 0u;
#pragma unroll
        for (unsigned j = 0; j < 16; ++j) { const unsigned c = xb_ld(&bar[XB_XCNT(j)]); sum += c; cnt += (c > 0u) ? 1u : 0u; mine = (j == x) ? c : mine; }
        if (sum == G) break;
        __builtin_amdgcn_s_sleep(1);
        if ((++sp & 255u) == 0u) { if (xb_ld(&bar[XB_TMO])) break; if (sp > XB_SPIN_CAP) { atomicAdd(&bar[XB_TMO], 1u); break; } }
    }
    nloc = mine > 0u ? mine : 1u; nx = cnt > 0u ? cnt : 1u;
}
__device__ __forceinline__ void xcd_barrier(const XcdBarrier& b) {
    asm volatile("s_waitcnt vmcnt(0)" ::: "memory");
    __syncthreads();
    if (threadIdx.x == 0) {
        unsigned* bar = b.bar;
        __builtin_amdgcn_s_waitcnt(0);
        unsigned nloc = b.st[0], nx = b.st[1];
        if (nloc == 0u) { xcd_barrier_complete(bar, b.x, nloc, nx); b.st[0] = nloc; b.st[1] = nx; }
        const unsigned old = xb_add(&bar[XB_XSUB(b.x)], 1u);
        const unsigned gen = old / nloc;
        if (old + 1u == (gen + 1u) * nloc) {
            __builtin_amdgcn_fence(__ATOMIC_RELEASE, "agent");
            asm volatile("s_waitcnt vmcnt(0)" ::: "memory");
            const unsigned og = xb_add(&bar[XB_TOP], 1u);
            const unsigned tg = og / nx;
            if (og + 1u == (tg + 1u) * nx) xb_add(&bar[XB_TOPGEN], 1u);
            else XB_SPIN(xb_ld(&bar[XB_TOPGEN]) == tg, bar);
            __builtin_amdgcn_fence(__ATOMIC_ACQUIRE, "agent");
            xb_add(&bar[XB_XGEN(b.x)], 1u);
            asm volatile("s_waitcnt vmcnt(0)" ::: "memory");
        } else {
            XB_SPIN(xb_ld(&bar[XB_XGEN(b.x)]) == gen, bar);
            __builtin_amdgcn_fence(__ATOMIC_ACQUIRE, "agent");
            asm volatile("s_waitcnt vmcnt(0)" ::: "memory");
        }
    }
    __syncthreads();
}

__device__ __forceinline__ float wave_sum(float v) {
#pragma unroll
    for (int o = 1; o < 64; o <<= 1) v += __shfl_xor(v, o);
    return v;
}
__device__ __forceinline__ int rope_pinv(int i) { return (i < 16) ? (8 * (i >> 2) + (i & 3)) : (8 * ((i - 16) >> 2) + 4 + (i & 3)); }
__device__ __forceinline__ int map_win(int n) {
    if (n < 384) return n;
    if (n < 640) return n;
    if (n < 672) return 4736 + rope_pinv(n - 640);
    if (n < 1184) return 1664 + (n - 672);
    if (n < 1440) return 640 + (n - 1184);
    if (n < 1696) return 896 + (n - 1440);
    if (n < 2208) return 1152 + (n - 1696);
    if (n < 2224) return 4768 + (n - 2208);
    if (n < 2736) return 2176 + (n - 2224);
    if (n < 3760) return 2688 + (n - 2736);
    return 3712 + (n - 3760);
}
__device__ __forceinline__ int map_wuq(int n) { const int hh = n / 96, r = n % 96; return (r < 64) ? n : hh * 96 + 64 + rope_pinv(r - 64); }
template <int MAP> __device__ __forceinline__ void p0_transpose_item(const float* W, int K, int N, bf16_t* WT, int ldk, int kcol_off, const float* gain, LAS float* scr, int item, int lane) {
    const int nblk = (N + 31) / 32, kb = item / nblk, nb = item % nblk, k0 = 64 * kb, n0 = 32 * nb;
    const bool inb = (n0 + (lane & 31)) < N;
#pragma unroll 8
    for (int i = 0; i < 32; ++i) { const int kk = 2 * i + (lane >> 5); float v = inb ? W[(size_t)(k0 + kk) * N + n0 + (lane & 31)] : 0.f; if (gain) v *= gain[k0 + kk]; scr[kk * 33 + (lane & 31)] = v; }
    LDS_WAIT(); asm volatile("" ::: "memory");
    const int c = lane & 7;
#pragma unroll
    for (int j = 0; j < 4; ++j) { const int n = (lane >> 3) + 8 * j; const LAS float* s = scr + (8 * c) * 33 + n;
        u32x4 o; o.x = cvt_pk_bf16(s[0 * 33], s[1 * 33]); o.y = cvt_pk_bf16(s[2 * 33], s[3 * 33]); o.z = cvt_pk_bf16(s[4 * 33], s[5 * 33]); o.w = cvt_pk_bf16(s[6 * 33], s[7 * 33]);
        const int ns = n0 + n;
        if (ns < N) { const int nd = (MAP == 1) ? map_win(ns) : (MAP == 2) ? map_wuq(ns) : ns; *(GAS u32x4*)(WT + (size_t)nd * ldk + kcol_off + k0 + 8 * c) = o; } }
    LDS_WAIT(); asm volatile("" ::: "memory");
}

__device__ const float ROPE_INVF[16] = {1.0f, 0.5623413324356079f, 0.3162277638912201f, 0.17782793939113617f, 0.10000000149011612f, 0.05623412877321243f, 0.03162277862429619f, 0.017782794311642647f,
    0.009999999776482582f, 0.005623413249850273f, 0.003162277862429619f, 0.0017782794311642647f, 0.0010000000474974513f, 0.000562341301701963f, 0.0003162277862429619f, 0.00017782794020604342f};

struct Args { const void* in[20]; float* out; unsigned char* ws; };
#define IN_F(k) ((const float*)args.in[k])
#define WSB(off) ((bf16_t*)(args.ws + (off)))
#define WSF(off) ((float*)(args.ws + (off)))


__global__ void __launch_bounds__(NWAVES * 64, 2) hybrid_fwd(Args args) {
    extern __shared__ __attribute__((aligned(16))) unsigned char lds_raw[];
    LAS unsigned char* lds = (LAS unsigned char*)lds_raw;
    volatile LAS unsigned* MISC = (volatile LAS unsigned*)(lds + MISC_OFF);
    const int tid0 = threadIdx.x, wave = __builtin_amdgcn_readfirstlane(tid0 >> 6);
    const int G = gridDim.x; const int bx = blockIdx.x; const int vcu = (G % 8 == 0) ? (bx % 8) * (G / 8) + bx / 8 : bx;
    gu32* ctl = (gu32*)(args.ws + WS_CTL);
    for (int u = tid0; u < (LDS_BYTES - LDSCTL_OFF) / 4; u += NWAVES * 64) ((LAS unsigned*)(lds + LDSCTL_OFF))[u] = 0u;
    __syncthreads();
    XcdBarrier bar = xcd_barrier_post((unsigned*)(ctl + CW_BAR), MISC + 8);
#define GRID_BAR() xcd_barrier(bar)
#define PHASE_IDS() int tid = threadIdx.x; asm volatile("" : "+v"(tid)); const int lane = tid & 63; (void)lane

    if (PHMASK & 1) {
        PHASE_IDS();
        LAS float* scr = (LAS float*)(lds + RING_OFF + wave * 16384);
        const int gw = vcu * NWAVES + wave, NGW = G * NWAVES;
        constexpr int I_IN = (1024 / 64) * ((NIN_REAL + 31) / 32), I_UQ = (384 / 64) * (768 / 32), I_UKV = (256 / 64) * (1024 / 32), I_BR = (512 / 64) * (1024 / 32),
                      I_OUT = (1024 / 64) * (1024 / 32), I_PLE = (256 / 64) * (1024 / 32), I_PLEG = I_OUT;
        constexpr int NITEMS = I_IN + I_UQ + I_UKV + 2 * I_BR + I_OUT + I_PLE + I_PLEG;
        for (int it = gw; it < NITEMS; it += NGW) {
            int r = it;
            if (r < I_IN) { p0_transpose_item<1>(IN_F(4), 1024, NIN_REAL, WSB(WS_WIN), 1024, 0, nullptr, scr, r, lane); continue; } r -= I_IN;
            if (r < I_UQ) { p0_transpose_item<2>(IN_F(6), 384, 768, WSB(WS_WUQ), 384, 0, IN_F(5), scr, r, lane); continue; } r -= I_UQ;
            if (r < I_UKV) { p0_transpose_item<0>(IN_F(8), 256, 1024, WSB(WS_WUKV), 256, 0, IN_F(7), scr, r, lane); continue; } r -= I_UKV;
            if (r < I_BR) { p0_transpose_item<0>(IN_F(12), 512, 1024, WSB(WS_WCAT), 1024, 0, nullptr, scr, r, lane); continue; } r -= I_BR;
            if (r < I_BR) { p0_transpose_item<0>(IN_F(13), 512, 1024, WSB(WS_WCAT), 1024, 512, nullptr, scr, r, lane); continue; } r -= I_BR;
            if (r < I_OUT) { p0_transpose_item<0>(IN_F(14), 1024, 1024, WSB(WS_WOUT), 1024, 0, nullptr, scr, r, lane); continue; } r -= I_OUT;
            if (r < I_PLE) { p0_transpose_item<0>(IN_F(15), 256, 1024, WSB(WS_WPLE), 256, 0, nullptr, scr, r, lane); continue; } r -= I_PLE;
            p0_transpose_item<0>(IN_F(18), 1024, 1024, WSB(WS_WPLEG), 1024, 0, IN_F(17), scr, r, lane);
        }
        { const int gt = vcu * (NWAVES * 64) + tid, NT_ = G * NWAVES * 64; const int npad = (NIN - NIN_REAL) * 1024 / 8; bf16_t* W_IN = WSB(WS_WIN);
          for (int i = gt; i < npad; i += NT_) *(GAS u32x4*)(W_IN + (size_t)NIN_REAL * 1024 + (size_t)i * 8) = (u32x4){0u, 0u, 0u, 0u}; }
        { const float* x = IN_F(0); const float* p_in = IN_F(1); const float* norm_in_g = IN_F(3); bf16_t* HB = WSB(WS_H); bf16_t* PB = WSB(WS_PB);
        for (int m = gw; m < M; m += NGW) {
            const GAS f32x4* xr = (const GAS f32x4*)(x + (size_t)m * D) + lane;
            f32x4 v[4]; float s2 = 0.f;
#pragma unroll
            for (int j = 0; j < 4; ++j) { v[j] = xr[64 * j]; s2 += (v[j][0] * v[j][0] + v[j][1] * v[j][1]) + (v[j][2] * v[j][2] + v[j][3] * v[j][3]); }
            const float rs = rsq(wave_sum(s2) * (1.f / D) + EPS);
            GAS u32x2* o8 = (GAS u32x2*)(HB + (size_t)m * D) + lane;
#pragma unroll
            for (int j = 0; j < 4; ++j) { const f32x4 gg = *((const GAS f32x4*)norm_in_g + lane + 64 * j); u32x2 w2; w2.x = cvt_pk_bf16(v[j][0] * rs * gg[0], v[j][1] * rs * gg[1]); w2.y = cvt_pk_bf16(v[j][2] * rs * gg[2], v[j][3] * rs * gg[3]); o8[64 * j] = w2; }
            const f32x4 pv = *((const GAS f32x4*)(p_in + (size_t)m * 256) + lane);
            u32x2 pw; pw.x = cvt_pk_bf16(pv[0], pv[1]); pw.y = cvt_pk_bf16(pv[2], pv[3]); *((GAS u32x2*)(PB + (size_t)m * 256) + lane) = pw;
        } }
        { const int gt = vcu * (NWAVES * 64) + tid, NT_ = G * NWAVES * 64; const int* positions = (const int*)args.in[2]; float* ROPE = WSF(WS_ROPE);
          for (int i = gt; i < M * 16; i += NT_) { const int m = i >> 4, k = i & 15; const float ang = (float)positions[m] * ROPE_INVF[k];
              const double rev = (double)ang * 0.15915494309189535; const double fr = rev - __builtin_rint(rev); const float f = (float)fr;
              ROPE[2 * (size_t)i] = __builtin_amdgcn_cosf(f); ROPE[2 * (size_t)i + 1] = __builtin_amdgcn_sinf(f); } }
    }
    GRID_BAR();

    if (PHMASK & 2) {
        pg8::Gemm g{WSB(WS_H), WSB(WS_WIN), M, NIN, 1024, 1024}; pg8::StaticOrder S; S.init(M, NIN, G, bx);
        pg8::EpiProj E{WSB(WS_CQ), WSB(WS_CKV), WSB(WS_GQ), WSB(WS_GK), WSB(WS_GV), WSB(WS_ACAT), WSB(WS_SMA), WSB(WS_SMB), WSB(WS_SMALL), WSF(WS_SSQA), WSF(WS_ROPE)};
        pg8::gemm_phase<pg8::EpiProj, pg8::StaticOrder, true, true>(lds + RING_OFF, g, S, E);
    }
    GRID_BAR();

    if (PROBE_DUP & 2) {
        pg8::Gemm g{WSB(WS_H), WSB(WS_WIN), M, NIN, 1024, 1024}; pg8::StaticOrder S; S.init(M, NIN, G, bx);
        pg8::EpiProj E{WSB(WS_CQ), WSB(WS_CKV), WSB(WS_GQ), WSB(WS_GK), WSB(WS_GV), WSB(WS_ACAT), WSB(WS_SMA), WSB(WS_SMB), WSB(WS_SMALL), WSF(WS_SSQA), WSF(WS_ROPE)};
        pg8::gemm_phase<pg8::EpiProj, pg8::StaticOrder, true, true>(lds + RING_OFF, g, S, E);
        GRID_BAR();
    }
    {
        PHASE_IDS();
        bf16_t* gsc = (bf16_t*)args.out;
        for (int c = bx * NWAVES + wave; c < 2048; c += G * NWAVES)
            gla2::g1_wave(c, WSB(WS_GQ), WSB(WS_GK), WSB(WS_GV), WSB(WS_SMALL), IN_F(9), IN_F(10), gsc + 48 * MiB, gsc + 56 * MiB, (float*)gsc, WSF(WS_SSQ1), lds + RING_OFF + wave * gla2::WREG, lane);
        __syncthreads();
    }
    if (PHMASK & 4) {
        pg8::Gemm g{WSB(WS_CQ), WSB(WS_WUQ), M, 768, 384, 384}; pg8::StaticOrder S; S.init(M, 768, G, bx);
        pg8::EpiQ E{WSB(WS_Q), WSF(WS_SSQA), WSF(WS_ROPE)};
        pg8::gemm_phase<pg8::EpiQ, pg8::StaticOrder, true, true>(lds + RING_OFF, g, S, E);
    }
    if (PHMASK & 8) {
        pg8::Gemm g{WSB(WS_CKV), WSB(WS_WUKV), M, 1024, 256, 256}; pg8::StaticOrder S; S.init(M, 1024, G, bx);
        pg8::EpiKV E{WSB(WS_KV), WSF(WS_SSQA)};
        pg8::gemm_phase<pg8::EpiKV, pg8::StaticOrder, true, true>(lds + RING_OFF, g, S, E);
    }
    GRID_BAR();

    if (PROBE_DUP & 4) {
        { pg8::Gemm g{WSB(WS_CQ), WSB(WS_WUQ), M, 768, 384, 384}; pg8::StaticOrder S; S.init(M, 768, G, bx);
          pg8::EpiQ E{WSB(WS_Q), WSF(WS_SSQA), WSF(WS_ROPE)};
          pg8::gemm_phase<pg8::EpiQ, pg8::StaticOrder, true, true>(lds + RING_OFF, g, S, E); }
        { pg8::Gemm g{WSB(WS_CKV), WSB(WS_WUKV), M, 1024, 256, 256}; pg8::StaticOrder S; S.init(M, 1024, G, bx);
          pg8::EpiKV E{WSB(WS_KV), WSF(WS_SSQA)};
          pg8::gemm_phase<pg8::EpiKV, pg8::StaticOrder, true, true>(lds + RING_OFF, g, S, E); }
        GRID_BAR();
    }
    {
        PHASE_IDS();
        bf16_t* gsc = (bf16_t*)args.out;
        for (int gid = bx * (NWAVES * 64) + tid; gid < 64 * 2048; gid += G * NWAVES * 64) gla2::g2_thread(gid, (const float*)gsc, WSF(WS_SSQ1), gsc + 32 * MiB);
    }
    GRID_BAR();
    {
        PHASE_IDS();
        bf16_t* gsc = (bf16_t*)args.out;
        for (int c = bx * NWAVES + wave; c < 2048; c += G * NWAVES)
            gla2::g3_wave(c, gsc + 48 * MiB, gsc + 56 * MiB, WSB(WS_GV), gsc + 32 * MiB, IN_F(11), WSB(WS_ACAT), lds + RING_OFF + wave * gla2::WREG, lane);
        __syncthreads();
        const int myq = (int)(bar.x & 7u);
        for (int dq = 0; dq < 8; ++dq) {
            const int qj = (myq + dq) & 7;
            for (;;) {
                if (tid == 0) MISC[4] = __hip_atomic_fetch_add((unsigned*)(ctl + CW_Q + 64 * qj), 1u, RLX_AGENT);
                __syncthreads();
                const int it = (int)MISC[4];
                __syncthreads();
                if (it >= 128) break;
                att::attn_unit(it & 15, qj, 7 - (it >> 4), WSB(WS_Q), WSB(WS_KV), WSB(WS_SMALL), WSB(WS_ACAT), lds + RING_OFF);
            }
        }
    }
    GRID_BAR();

    if (PHMASK & 0x40) {
        pg8::Gemm g{WSB(WS_ACAT), WSB(WS_WCAT), M, 1024, 1024, 1024}; pg8::StaticOrder S; S.init(M, 1024, G, bx);
        pg8::EpiMerge E{WSB(WS_SMA), WSB(WS_SMB), WSB(WS_MERGED)};
        pg8::gemm_phase<pg8::EpiMerge, pg8::StaticOrder, true, true>(lds + RING_OFF, g, S, E);
    }
    GRID_BAR();

    if (PROBE_DUP & 16) {
        pg8::Gemm g{WSB(WS_ACAT), WSB(WS_WCAT), M, 1024, 1024, 1024}; pg8::StaticOrder S; S.init(M, 1024, G, bx);
        pg8::EpiMerge E{WSB(WS_SMA), WSB(WS_SMB), WSB(WS_MERGED)};
        pg8::gemm_phase<pg8::EpiMerge, pg8::StaticOrder, true, true>(lds + RING_OFF, g, S, E);
        GRID_BAR();
    }
    if (PHMASK & 0x80) {
        pg8::Gemm g{WSB(WS_MERGED), WSB(WS_WOUT), M, 1024, 1024, 1024}; pg8::StaticOrder S; S.init(M, 1024, G, bx);
        pg8::EpiX1 E{IN_F(0), args.out, WSB(WS_X1B), WSF(WS_SSQ1)};
        pg8::gemm_phase<pg8::EpiX1, pg8::StaticOrder, true, true>(lds + RING_OFF, g, S, E);
    }
    if (PHMASK & 0x100) {
        pg8::Gemm g{WSB(WS_PB), WSB(WS_WPLE), M, 1024, 256, 256}; pg8::StaticOrder S; S.init(M, 1024, G, bx);
        pg8::EpiE E{WSB(WS_E), WSF(WS_SSQE)};
        pg8::gemm_phase<pg8::EpiE, pg8::StaticOrder, true, true>(lds + RING_OFF, g, S, E);
    }
    GRID_BAR();

    if (PROBE_DUP & 32) {
        { pg8::Gemm g{WSB(WS_MERGED), WSB(WS_WOUT), M, 1024, 1024, 1024}; pg8::StaticOrder S; S.init(M, 1024, G, bx);
          pg8::EpiX1 E{IN_F(0), args.out, WSB(WS_X1B), WSF(WS_SSQ1)};
          pg8::gemm_phase<pg8::EpiX1, pg8::StaticOrder, true, true>(lds + RING_OFF, g, S, E); }
        { pg8::Gemm g{WSB(WS_PB), WSB(WS_WPLE), M, 1024, 256, 256}; pg8::StaticOrder S; S.init(M, 1024, G, bx);
          pg8::EpiE E{WSB(WS_E), WSF(WS_SSQE)};
          pg8::gemm_phase<pg8::EpiE, pg8::StaticOrder, true, true>(lds + RING_OFF, g, S, E); }
        GRID_BAR();
    }
    if (PROBE_DUP & 64) {
        pg8::Gemm g{WSB(WS_X1B), WSB(WS_WPLEG), M, 1024, 1024, 1024}; pg8::StaticOrder S; S.init(M, 1024, G, bx);
        pg8::EpiG E{WSF(WS_SSQ1), WSF(WS_SSQE), WSB(WS_E), IN_F(16), WSF(WS_ACAT), WSF(WS_SSQA)};
        pg8::gemm_phase<pg8::EpiG, pg8::StaticOrder, true, true>(lds + RING_OFF, g, S, E);
        GRID_BAR();
    }
    if (PHMASK & 0x200) {
        pg8::Gemm g{WSB(WS_X1B), WSB(WS_WPLEG), M, 1024, 1024, 1024}; pg8::StaticOrder S; S.init(M, 1024, G, bx);
        pg8::EpiG E{WSF(WS_SSQ1), WSF(WS_SSQE), WSB(WS_E), IN_F(16), args.out, WSF(WS_SSQ2)};
        pg8::gemm_phase<pg8::EpiG, pg8::StaticOrder, true, true>(lds + RING_OFF, g, S, E);
    }
    GRID_BAR();

    if (PHMASK & 0x400) {
        PHASE_IDS();
        const int gw = vcu * NWAVES + wave, NGW = G * NWAVES;
        const unsigned tmo = __hip_atomic_load((unsigned*)(ctl + CW_BAR) + XB_TMO, RLX_AGENT);
        const float* final_norm_g = IN_F(19); float* out = args.out; const float* SSQ2 = WSF(WS_SSQ2);
        for (int m = gw; m < M; m += NGW) {
            const float sv = (lane < 16) ? SSQ2[(size_t)m * 16 + lane] : 0.f;
            float rs = rsq(wave_sum(sv) * (1.f / D) + EPS);
            if (tmo) rs = __builtin_nanf("");
            GAS f32x4* xr = (GAS f32x4*)(out + (size_t)m * D) + lane;
#pragma unroll
            for (int j = 0; j < 4; ++j) { const f32x4 gg = *((const GAS f32x4*)final_norm_g + lane + 64 * j); f32x4 v = xr[64 * j]; v = v * rs * gg; xr[64 * j] = v; }
        }
    }
}

extern "C" void kernel_launch(void* const* d_in, const int* in_sizes, int n_in, void* d_out, int out_size, void* d_ws, size_t ws_size, hipStream_t stream) {
    static int grid = 0;
    if (grid == 0) {
        if (n_in != 20 || in_sizes[0] != M * D || out_size != M * D || ws_size < WS_END) {
            fprintf(stderr, "kernel_launch: unexpected shapes (n_in %d, in0 %d, out %d, ws %zu; need ws >= %zu); nothing launched\n", n_in, n_in > 0 ? in_sizes[0] : -1, out_size, ws_size, (size_t)WS_END); grid = -1; return; }
        int dev = 0, cus = 0, per_cu = 0;
        if (hipGetDevice(&dev) != hipSuccess || hipDeviceGetAttribute(&cus, hipDeviceAttributeMultiprocessorCount, dev) != hipSuccess) { fprintf(stderr, "kernel_launch: device query failed\n"); grid = -1; return; }
        if (hipFuncSetAttribute((const void*)hybrid_fwd, hipFuncAttributeMaxDynamicSharedMemorySize, LDS_BYTES) != hipSuccess) { fprintf(stderr, "kernel_launch: hipFuncSetAttribute failed\n"); grid = -1; return; }
        if (hipOccupancyMaxActiveBlocksPerMultiprocessor(&per_cu, (const void*)hybrid_fwd, NWAVES * 64, LDS_BYTES) != hipSuccess || per_cu < 1)
            fprintf(stderr, "kernel_launch: note: occupancy query reports %d workgroups per CU\n", per_cu);
        (void)hipGetLastError();
        grid = cus;
    }
    if (grid < 0) return;
    if (hipMemsetAsync((char*)d_ws + WS_CTL, 0, CTL_ZERO_BYTES, stream) != hipSuccess) { fprintf(stderr, "kernel_launch: hipMemsetAsync failed\n"); return; }
    Args a{};
    for (int i = 0; i < 20; ++i) a.in[i] = d_in[i];
    a.out = (float*)d_out; a.ws = (unsigned char*)d_ws;
    hipLaunchKernelGGL(hybrid_fwd, dim3(grid), dim3(NWAVES * 64), LDS_BYTES, stream, a);
    const hipError_t le = hipPeekAtLastError();
    if (le != hipSuccess) fprintf(stderr, "kernel_launch: launch failed: %s\n", hipGetErrorName(le));
}
```

```cpp
#include <hip/hip_runtime.h>
#include <hip/hip_bf16.h>
#include <cstdio>
#include <cstdint>
#include <cmath>

#define LAS __attribute__((address_space(3)))
#define GAS __attribute__((address_space(1)))
typedef unsigned short bf16_t;
typedef short bf16x8 __attribute__((ext_vector_type(8)));
typedef short s16x4 __attribute__((ext_vector_type(4)));
typedef float f32x4 __attribute__((ext_vector_type(4)));
typedef float f32x16 __attribute__((ext_vector_type(16)));
typedef unsigned u32x4 __attribute__((ext_vector_type(4)));
typedef unsigned u32x2 __attribute__((ext_vector_type(2)));

constexpr int NB = 16, SEQ = 2048, M = NB * SEQ, D = 1024;
constexpr int NIN = 4864;
constexpr int NIN_REAL = 4784;
constexpr float EPS = 1e-6f;
constexpr float LOG2E = 1.4426950408889634f;
constexpr float C2Q = 0.10206207261596577f * LOG2E;

typedef float f32x2_t __attribute__((ext_vector_type(2))); typedef __bf16 bf16x2_t __attribute__((ext_vector_type(2)));
__device__ __forceinline__ unsigned cvt_pk_bf16(float lo, float hi) { f32x2_t v = {lo, hi}; bf16x2_t b = __builtin_convertvector(v, bf16x2_t); return __builtin_bit_cast(unsigned, b); }
__device__ __forceinline__ float bflo(unsigned w) { return __uint_as_float(w << 16); }
__device__ __forceinline__ float bfhi(unsigned w) { return __uint_as_float(w & 0xffff0000u); }
__device__ __forceinline__ float bf1(bf16_t b) { return __uint_as_float((unsigned)b << 16); }
__device__ __forceinline__ float sigm(float x) { return __builtin_amdgcn_rcpf(1.f + __builtin_amdgcn_exp2f(-LOG2E * x)); }
__device__ __forceinline__ float rsq(float x) { return __builtin_amdgcn_rsqf(x); }

namespace pg8 {
constexpr int BM = 256, BK = 64, HALF = 128, HTB = HALF * BK * 2, STAGE_BYTES = 8 * HTB, NXCD = 8, WGM = 8;
__host__ __device__ __forceinline__ int lds_byte(int r, int c) { const int st = (r >> 4) * 2 + (c >> 5), rr = r & 15, cc = c & 31, ob = rr * 64 + cc * 2; return st * 1024 + (ob ^ (((ob >> 9) & 1) << 5)); }
__host__ __device__ __forceinline__ void stage_rc(int b, int& R, int& C) { const int st = b / 1024, sb = b % 1024, swz = sb ^ (((sb >> 9) & 1) << 5); R = (st >> 1) * 16 + swz / 64; C = (st & 1) * 32 + (swz % 64) / 2; }
__host__ __device__ __forceinline__ int perm32(int rho) { const int n = rho >> 4, i = rho & 15; return 8 * (i >> 2) + 4 * n + (i & 3); }

struct Unit { int pm, pn; };
struct Gemm { const bf16_t* A; const bf16_t* Bt; int M, N, K, lda; };

struct StaticOrder {
    int nM, nN, nwg, G, c;
    __host__ __device__ void init(int M_, int N_, int G_, int c_) { nM = M_ / BM; nN = N_ / BM; nwg = nM * nN; G = G_; c = c_; }
    __host__ __device__ bool next(int i, Unit& u) const {
        const long L = (long)i * G + c; if (L >= nwg) return false;
        int wgid = (int)L; { const int q = nwg / NXCD, r = nwg % NXCD, xcd = wgid % NXCD, off = wgid / NXCD; wgid = (xcd < r ? xcd * (q + 1) : r * (q + 1) + (xcd - r) * q) + off; }
        const int nig = WGM * nN, gid = wgid / nig, fm = gid * WGM, gsz = (nM - fm) < WGM ? (nM - fm) : WGM;
        u.pm = fm + ((wgid % nig) % gsz); u.pn = (wgid % nig) / gsz; return true;
    }
};

typedef f32x4 Acc[2][2][4][2];

__device__ __forceinline__ float sum8sq(const f32x4& a, const f32x4& b) { return (a[0] * a[0] + a[1] * a[1]) + (a[2] * a[2] + a[3] * a[3]) + (b[0] * b[0] + b[1] * b[1]) + (b[2] * b[2] + b[3] * b[3]); }
__device__ __forceinline__ float red_fq(float s) { s += __shfl_xor(s, 16); s += __shfl_xor(s, 32); return s; }
__device__ __forceinline__ u32x4 pack8(const f32x4& a, const f32x4& b) { u32x4 w; w.x = cvt_pk_bf16(a[0], a[1]); w.y = cvt_pk_bf16(a[2], a[3]); w.z = cvt_pk_bf16(b[0], b[1]); w.w = cvt_pk_bf16(b[2], b[3]); return w; }

struct EpiProj {
    static constexpr bool PERM = true, HAS_MID = false;
    bf16_t *cq, *ckv, *gq, *gk, *gv, *acat, *sma, *smb, *small; float* ssqa; const float* rope;
    __device__ __forceinline__ void mid(Acc&, const Unit&, int, int, int, int) const {}
    __device__ __forceinline__ void operator()(const Acc& acc, const Unit& u, int wr, int wc, int fr, int fq) const {
#pragma unroll
        for (int bj = 0; bj < 2; ++bj) {
            const int hb = 2 * u.pn + bj;
            bf16_t* dst; int ldc, coff, act = 0;
            if (hb < 3) { dst = cq; ldc = 384; coff = hb * 128; }
            else if (hb < 5) { dst = ckv; ldc = 256; coff = (hb - 3) * 128; }
            else if (hb < 7) { dst = gq; ldc = 256; coff = (hb - 5) * 128; }
            else if (hb < 9) { dst = gk; ldc = 256; coff = (hb - 7) * 128; }
            else if (hb < 13) { dst = gv; ldc = 512; coff = (hb - 9) * 128; }
            else if (hb < 21) { dst = acat; ldc = 1024; coff = (hb - 13) * 128; act = 1; }
            else if (hb < 29) { dst = sma; ldc = 1024; coff = (hb - 21) * 128; act = 2; }
            else if (hb < 37) { dst = smb; ldc = 1024; coff = (hb - 29) * 128; act = 2; }
            else { dst = small; ldc = 128; coff = 0; act = (wc == 0) ? 3 : 0; }
            const bool dosq = hb < 5;
#pragma unroll
            for (int ai = 0; ai < 2; ++ai)
#pragma unroll
                for (int m = 0; m < 4; ++m) {
                    const int row = u.pm * BM + ai * HALF + wr * 64 + m * 16 + fr;
                    f32x4 v0 = acc[ai][bj][m][0], v1 = acc[ai][bj][m][1];
                    if (dosq) { const float s = red_fq(sum8sq(v0, v1)); if (fq == 0) ssqa[(size_t)row * 32 + hb * 4 + wc] = s; }
                    if (act == 1) {
#pragma unroll
                        for (int e = 0; e < 4; ++e) { v0[e] = v0[e] * sigm(v0[e]); v1[e] = v1[e] * sigm(v1[e]); }
                    } else if (act == 2) {
#pragma unroll
                        for (int e = 0; e < 4; ++e) { v0[e] = sigm(v0[e]); v1[e] = sigm(v1[e]); }
                    } else if (act == 3) {
                        const f32x4* rp = (const f32x4*)(rope + (size_t)row * 32 + 8 * fq); const f32x4 r0 = rp[0], r1 = rp[1];
                        const float c[4] = {r0[0], r0[2], r1[0], r1[2]}, s[4] = {r0[1], r0[3], r1[1], r1[3]};
#pragma unroll
                        for (int e = 0; e < 4; ++e) { const float x1 = v0[e], x2 = v1[e]; v0[e] = x1 * c[e] - x2 * s[e]; v1[e] = x2 * c[e] + x1 * s[e]; }
                    }
                    *(u32x4*)(dst + (size_t)row * ldc + coff + wc * 32 + 8 * fq) = pack8(v0, v1);
                }
        }
    }
};

struct EpiQ {
    static constexpr bool PERM = true, HAS_MID = false;
    bf16_t* q; const float* ssqa; const float* rope;
    __device__ __forceinline__ void mid(Acc&, const Unit&, int, int, int, int) const {}
    __device__ __forceinline__ void operator()(const Acc& acc, const Unit& u, int wr, int wc, int fr, int fq) const {
#pragma unroll
        for (int ai = 0; ai < 2; ++ai)
#pragma unroll
            for (int m = 0; m < 4; ++m) {
                const int row = u.pm * BM + ai * HALF + wr * 64 + m * 16 + fr;
                const f32x4* sp = (const f32x4*)(ssqa + (size_t)row * 32); const f32x4 a = sp[0], b = sp[1], c = sp[2];
                const float tot = ((a[0] + a[1]) + (a[2] + a[3])) + ((b[0] + b[1]) + (b[2] + b[3])) + ((c[0] + c[1]) + (c[2] + c[3]));
                const float rs = rsq(tot * (1.f / 384.f) + EPS) * C2Q;
#pragma unroll
                for (int bj = 0; bj < 2; ++bj) {
                    const int grp = 8 * u.pn + 4 * bj + wc;
                    f32x4 v0 = acc[ai][bj][m][0] * rs, v1 = acc[ai][bj][m][1] * rs;
                    if ((grp % 3) == 2) {
                        const f32x4* rp = (const f32x4*)(rope + (size_t)row * 32 + 8 * fq); const f32x4 r0 = rp[0], r1 = rp[1];
                        const float cc[4] = {r0[0], r0[2], r1[0], r1[2]}, ss[4] = {r0[1], r0[3], r1[1], r1[3]};
#pragma unroll
                        for (int e = 0; e < 4; ++e) { const float x1 = v0[e], x2 = v1[e]; v0[e] = x1 * cc[e] - x2 * ss[e]; v1[e] = x2 * cc[e] + x1 * ss[e]; }
                    }
                    *(u32x4*)(q + (size_t)row * 768 + u.pn * BM + bj * HALF + wc * 32 + 8 * fq) = pack8(v0, v1);
                }
            }
    }
};
struct EpiKV {
    static constexpr bool PERM = true, HAS_MID = false;
    bf16_t* kv; const float* ssqa;
    __device__ __forceinline__ void mid(Acc&, const Unit&, int, int, int, int) const {}
    __device__ __forceinline__ void operator()(const Acc& acc, const Unit& u, int wr, int wc, int fr, int fq) const {
#pragma unroll
        for (int ai = 0; ai < 2; ++ai)
#pragma unroll
            for (int m = 0; m < 4; ++m) {
                const int row = u.pm * BM + ai * HALF + wr * 64 + m * 16 + fr;
                const f32x4* sp = (const f32x4*)(ssqa + (size_t)row * 32 + 12); const f32x4 a = sp[0], b = sp[1];
                const float tot = ((a[0] + a[1]) + (a[2] + a[3])) + ((b[0] + b[1]) + (b[2] + b[3]));
                const float rs = rsq(tot * (1.f / 256.f) + EPS);
#pragma unroll
                for (int bj = 0; bj < 2; ++bj) {
                    const f32x4 v0 = acc[ai][bj][m][0] * rs, v1 = acc[ai][bj][m][1] * rs;
                    *(u32x4*)(kv + (size_t)row * 1024 + u.pn * BM + bj * HALF + wc * 32 + 8 * fq) = pack8(v0, v1);
                }
            }
    }
};
struct EpiMerge {
    static constexpr bool PERM = true, HAS_MID = true;
    const bf16_t* sma; const bf16_t* smb; bf16_t* out;
    __device__ __forceinline__ void mid(Acc& acc, const Unit& u, int wr, int wc, int fr, int fq) const {
#pragma unroll
        for (int ai = 0; ai < 2; ++ai)
#pragma unroll
            for (int m = 0; m < 4; ++m) {
                const int row = u.pm * BM + ai * HALF + wr * 64 + m * 16 + fr;
#pragma unroll
                for (int bj = 0; bj < 2; ++bj) {
                    const size_t off = (size_t)row * 1024 + u.pn * BM + bj * HALF + wc * 32 + 8 * fq;
                    const u32x4 a = *(const u32x4*)(sma + off), b = *(const u32x4*)(smb + off);
#pragma unroll
                    for (int e = 0; e < 4; ++e) {
                        const unsigned aw = a[e], bw = b[e];
                        const float r0 = bflo(aw) * __builtin_amdgcn_rcpf(bflo(bw)), r1 = bfhi(aw) * __builtin_amdgcn_rcpf(bfhi(bw));
                        acc[ai][bj][m][e >> 1][(e & 1) * 2] *= r0; acc[ai][bj][m][e >> 1][(e & 1) * 2 + 1] *= r1;
                    }
                }
                asm volatile("" ::: "memory");
            }
    }
    __device__ __forceinline__ void operator()(const Acc& acc, const Unit& u, int wr, int wc, int fr, int fq) const {
#pragma unroll
        for (int ai = 0; ai < 2; ++ai)
#pragma unroll
            for (int m = 0; m < 4; ++m) {
                const int row = u.pm * BM + ai * HALF + wr * 64 + m * 16 + fr;
#pragma unroll
                for (int bj = 0; bj < 2; ++bj) {
                    const size_t off = (size_t)row * 1024 + u.pn * BM + bj * HALF + wc * 32 + 8 * fq;
                    const u32x4 b = *(const u32x4*)(smb + off);
                    f32x4 v0 = acc[ai][bj][m][0], v1 = acc[ai][bj][m][1];
                    v0[0] *= bflo(b[0]); v0[1] *= bfhi(b[0]); v0[2] *= bflo(b[1]); v0[3] *= bfhi(b[1]);
                    v1[0] *= bflo(b[2]); v1[1] *= bfhi(b[2]); v1[2] *= bflo(b[3]); v1[3] *= bfhi(b[3]);
                    *(u32x4*)(out + off) = pack8(v0, v1);
                }
            }
    }
};
struct EpiX1 {
    static constexpr bool PERM = true, HAS_MID = false;
    const float* x; float* x1; bf16_t* x1b; float* ssq1;
    __device__ __forceinline__ void mid(Acc&, const Unit&, int, int, int, int) const {}
    __device__ __forceinline__ void operator()(const Acc& acc, const Unit& u, int wr, int wc, int fr, int fq) const {
#pragma unroll
        for (int ai = 0; ai < 2; ++ai)
#pragma unroll
            for (int m = 0; m < 4; ++m) {
                const int row = u.pm * BM + ai * HALF + wr * 64 + m * 16 + fr; float sq = 0.f;
#pragma unroll
                for (int bj = 0; bj < 2; ++bj) {
                    const size_t off = (size_t)row * 1024 + u.pn * BM + bj * HALF + wc * 32 + 8 * fq;
                    const f32x4 xa = *(const f32x4*)(x + off), xb = *(const f32x4*)(x + off + 4);
                    const f32x4 v0 = acc[ai][bj][m][0] + xa, v1 = acc[ai][bj][m][1] + xb;
                    *(f32x4*)(x1 + off) = v0; *(f32x4*)(x1 + off + 4) = v1;
                    sq += sum8sq(v0, v1);
                    *(u32x4*)(x1b + off) = pack8(v0, v1);
                }
                sq = red_fq(sq); if (fq == 0) ssq1[(size_t)row * 16 + u.pn * 4 + wc] = sq;
            }
    }
};
struct EpiE {
    static constexpr bool PERM = true, HAS_MID = false;
    bf16_t* e; float* ssqe;
    __device__ __forceinline__ void mid(Acc&, const Unit&, int, int, int, int) const {}
    __device__ __forceinline__ void operator()(const Acc& acc, const Unit& u, int wr, int wc, int fr, int fq) const {
#pragma unroll
        for (int ai = 0; ai < 2; ++ai)
#pragma unroll
            for (int m = 0; m < 4; ++m) {
                const int row = u.pm * BM + ai * HALF + wr * 64 + m * 16 + fr; float sq = 0.f;
#pragma unroll
                for (int bj = 0; bj < 2; ++bj) {
                    const size_t off = (size_t)row * 1024 + u.pn * BM + bj * HALF + wc * 32 + 8 * fq;
                    const f32x4 v0 = acc[ai][bj][m][0], v1 = acc[ai][bj][m][1];
                    sq += sum8sq(v0, v1);
                    *(u32x4*)(e + off) = pack8(v0, v1);
                }
                sq = red_fq(sq); if (fq == 0) ssqe[(size_t)row * 16 + u.pn * 4 + wc] = sq;
            }
    }
};
struct EpiG {
    static constexpr bool PERM = true, HAS_MID = false;
    const float* ssq1; const float* ssqe; const bf16_t* e; const float* gple; float* xio; float* ssq2;
    __device__ __forceinline__ void mid(Acc&, const Unit&, int, int, int, int) const {}
    __device__ __forceinline__ float row16(const float* p) const {
        const f32x4* sp = (const f32x4*)p; const f32x4 a = sp[0], b = sp[1], c = sp[2], d = sp[3];
        return (((a[0] + a[1]) + (a[2] + a[3])) + ((b[0] + b[1]) + (b[2] + b[3]))) + (((c[0] + c[1]) + (c[2] + c[3])) + ((d[0] + d[1]) + (d[2] + d[3])));
    }
    __device__ __forceinline__ void operator()(const Acc& acc, const Unit& u, int wr, int wc, int fr, int fq) const {
#pragma unroll
        for (int ai = 0; ai < 2; ++ai)
#pragma unroll
            for (int m = 0; m < 4; ++m) {
                const int row = u.pm * BM + ai * HALF + wr * 64 + m * 16 + fr; float sq = 0.f;
                const float rs1 = rsq(row16(ssq1 + (size_t)row * 16) * (1.f / 1024.f) + EPS), rse = rsq(row16(ssqe + (size_t)row * 16) * (1.f / 1024.f) + EPS);
#pragma unroll
                for (int bj = 0; bj < 2; ++bj) {
                    const int col = u.pn * BM + bj * HALF + wc * 32 + 8 * fq; const size_t off = (size_t)row * 1024 + col;
                    const f32x4 xa = *(const f32x4*)(xio + off), xb = *(const f32x4*)(xio + off + 4);
                    const f32x4 ga = *(const f32x4*)(gple + col), gb = *(const f32x4*)(gple + col + 4);
                    const u32x4 ew = *(const u32x4*)(e + off);
                    const float ev[8] = {bflo(ew[0]), bfhi(ew[0]), bflo(ew[1]), bfhi(ew[1]), bflo(ew[2]), bfhi(ew[2]), bflo(ew[3]), bfhi(ew[3])};
                    f32x4 v0, v1;
#pragma unroll
                    for (int k = 0; k < 4; ++k) {
                        v0[k] = xa[k] + sigm(acc[ai][bj][m][0][k] * rs1) * (ev[k] * rse * ga[k]);
                        v1[k] = xb[k] + sigm(acc[ai][bj][m][1][k] * rs1) * (ev[4 + k] * rse * gb[k]);
                    }
                    *(f32x4*)(xio + off) = v0; *(f32x4*)(xio + off + 4) = v1;
                    sq += sum8sq(v0, v1);
                }
                sq = red_fq(sq); if (fq == 0) ssq2[(size_t)row * 16 + u.pn * 4 + wc] = sq;
            }
    }
};

template <class Epi, class Sched, bool ALIGN_EPI = false, bool SP2 = false>
__device__ __forceinline__ void gemm_phase(LAS unsigned char* lds, const Gemm g, const Sched& S, const Epi& E) {
    int tid_ = threadIdx.x; asm volatile("" : "+v"(tid_));
    const int tid = tid_, wid = __builtin_amdgcn_readfirstlane(tid >> 6), lane = tid & 63, wr = wid >> 2, wc = wid & 3, fr = lane & 15, fq = lane >> 4;
    const int K = g.K, nt = K / BK, lda = g.lda;
    unsigned voffA[2], voffB[2];
#pragma unroll
    for (int i = 0; i < 2; ++i) { int R, C; stage_rc(tid * 16 + i * 8192, R, C); const int Rb = Epi::PERM ? ((R & ~31) + perm32(R & 31)) : R;
        voffA[i] = (unsigned)(R * lda + C) * 2u; voffB[i] = (unsigned)(Rb * K + C) * 2u; }
    const size_t kstep = (size_t)(BK * 2);
    const size_t hstepA = (size_t)HALF * lda * 2, hstepB = (size_t)HALF * K * 2;
    const size_t tstepA = 2 * hstepA, tstepB = 2 * hstepB;
    const unsigned ldsw = (unsigned)wid * 1024u;
    const int aoff = lds_byte(wr * 64 + fr, fq * 8), boff = lds_byte(wc * 32 + fr, fq * 8);
#define PG8_SA(b, h) (((b) * 2 + (h)) * HTB)
#define PG8_SB(b, h) ((4 + (b) * 2 + (h)) * HTB)
#define PG8_STAGE(bufoff, gbase, voff) do { _Pragma("unroll") for (int _i = 0; _i < 2; ++_i) \
        __builtin_amdgcn_global_load_lds((const unsigned*)((const char*)(gbase) + (voff)[_i]), (LAS unsigned*)(lds + (bufoff) + ldsw + _i * 8192), 16, 0, 0); } while (0)
#define PG8_LDA(dst, b, h) do { _Pragma("unroll") for (int m = 0; m < 4; ++m) _Pragma("unroll") for (int k = 0; k < 2; ++k) dst[m][k] = *(const LAS bf16x8*)(lds + PG8_SA(b, h) + aoff + m * 2048 + k * 1024); } while (0)
#define PG8_LDB(dst, b, h) do { _Pragma("unroll") for (int n = 0; n < 2; ++n) _Pragma("unroll") for (int k = 0; k < 2; ++k) dst[n][k] = *(const LAS bf16x8*)(lds + PG8_SB(b, h) + boff + n * 2048 + k * 1024); } while (0)
#define PG8_MMA(ai, bj, At, Bt) do { __builtin_amdgcn_s_setprio(1); _Pragma("unroll") for (int m = 0; m < 4; ++m) _Pragma("unroll") for (int n = 0; n < 2; ++n) _Pragma("unroll") for (int k = 0; k < 2; ++k) \
        acc[ai][bj][m][n] = __builtin_amdgcn_mfma_f32_16x16x32_bf16(Bt[n][k], At[m][k], acc[ai][bj][m][n], 0, 0, 0); __builtin_amdgcn_s_setprio(0); } while (0)
#define PG8_WAIT_V(n) asm volatile("s_waitcnt vmcnt(" #n ")" ::: "memory")
#define PG8_WAIT_L(n) asm volatile("s_waitcnt lgkmcnt(" #n ")" ::: "memory")
#define PG8_BAR __builtin_amdgcn_s_barrier()
#define PG8_SCHED __builtin_amdgcn_sched_barrier(0)
    Unit cur, nxt; int ui = 0;
    if (!S.next(0, cur)) return;
    Acc acc;
#pragma unroll
    for (int a = 0; a < 2; ++a)
#pragma unroll
        for (int b = 0; b < 2; ++b)
#pragma unroll
            for (int m = 0; m < 4; ++m)
#pragma unroll
                for (int n = 0; n < 2; ++n) acc[a][b][m][n] = (f32x4){0.f, 0.f, 0.f, 0.f};
    bf16x8 At[4][2], B0[2][2], B1[2][2];
    const char* cA = (const char*)g.A + (size_t)cur.pm * tstepA; const char* cB = (const char*)g.Bt + (size_t)cur.pn * tstepB;
    if constexpr (SP2) {
        PG8_STAGE(PG8_SB(0, 0), cB, voffB); PG8_STAGE(PG8_SB(0, 1), cB + hstepB, voffB); PG8_STAGE(PG8_SA(0, 0), cA, voffA); PG8_STAGE(PG8_SA(0, 1), cA + hstepA, voffA);
        if (wr == 1) PG8_BAR;
        PG8_WAIT_V(2); PG8_BAR;
        PG8_STAGE(PG8_SB(1, 0), cB + kstep, voffB); PG8_STAGE(PG8_SA(1, 0), cA + kstep, voffA); PG8_STAGE(PG8_SB(1, 1), cB + hstepB + kstep, voffB);
        PG8_WAIT_V(6); PG8_BAR;
    } else {
        PG8_STAGE(PG8_SB(0, 0), cB, voffB); PG8_STAGE(PG8_SA(0, 0), cA, voffA); PG8_STAGE(PG8_SB(0, 1), cB + hstepB, voffB); PG8_STAGE(PG8_SA(0, 1), cA + hstepA, voffA);
        if (wr == 1) PG8_BAR;
        PG8_WAIT_V(4); PG8_BAR;
        PG8_STAGE(PG8_SB(1, 0), cB + kstep, voffB); PG8_STAGE(PG8_SA(1, 0), cA + kstep, voffA); PG8_STAGE(PG8_SB(1, 1), cB + hstepB + kstep, voffB);
        PG8_WAIT_V(6); PG8_BAR;
    }
    for (;;) {
        const bool has_next = S.next(ui + 1, nxt);
        const char* nA = has_next ? (const char*)g.A + (size_t)nxt.pm * tstepA : cA; const char* nB = has_next ? (const char*)g.Bt + (size_t)nxt.pn * tstepB : cB;
        auto kloop = [&](const int t0, const int t1) __attribute__((always_inline)) {
        for (int t = t0; t < t1; t += 2) {
            const bool last = (t == nt - 2);
            const char* a1 = cA + (size_t)(t + 1) * kstep;
            const char* a2 = last ? nA : cA + (size_t)(t + 2) * kstep; const char* b2 = last ? nB : cB + (size_t)(t + 2) * kstep;
            const char* a3 = a2 + kstep; const char* b3 = b2 + kstep;
            if constexpr (SP2) {
            PG8_LDB(B0, 0, 0); PG8_LDB(B1, 0, 1); PG8_SCHED; PG8_LDA(At, 0, 0); PG8_STAGE(PG8_SA(1, 1), a1 + hstepA, voffA);
            PG8_WAIT_V(8); PG8_WAIT_L(0); PG8_BAR; PG8_MMA(0, 0, At, B0); PG8_MMA(0, 1, At, B1); PG8_BAR; PG8_SCHED;
            PG8_LDA(At, 0, 1); PG8_STAGE(PG8_SB(0, 0), b2, voffB); PG8_STAGE(PG8_SB(0, 1), b2 + hstepB, voffB); PG8_STAGE(PG8_SA(0, 0), a2, voffA);
            PG8_WAIT_V(8); PG8_WAIT_L(0); PG8_BAR; PG8_MMA(1, 0, At, B0); PG8_MMA(1, 1, At, B1); PG8_BAR; PG8_SCHED;
            PG8_LDB(B0, 1, 0); PG8_LDB(B1, 1, 1); PG8_SCHED; PG8_LDA(At, 1, 0); PG8_STAGE(PG8_SA(0, 1), a2 + hstepA, voffA);
            PG8_WAIT_V(8); PG8_WAIT_L(0); PG8_BAR; PG8_MMA(0, 0, At, B0); PG8_MMA(0, 1, At, B1); PG8_BAR; PG8_SCHED;
            PG8_LDA(At, 1, 1); PG8_STAGE(PG8_SB(1, 0), b3, voffB); PG8_STAGE(PG8_SB(1, 1), b3 + hstepB, voffB); PG8_STAGE(PG8_SA(1, 0), a3, voffA);
            PG8_WAIT_V(8); PG8_WAIT_L(0); PG8_BAR; PG8_MMA(1, 0, At, B0); PG8_MMA(1, 1, At, B1); PG8_BAR; PG8_SCHED;
            } else {
            PG8_LDB(B0, 0, 0); PG8_SCHED; PG8_LDA(At, 0, 0); PG8_STAGE(PG8_SA(1, 1), a1 + hstepA, voffA);
            PG8_WAIT_L(8); PG8_BAR; PG8_WAIT_L(0); PG8_MMA(0, 0, At, B0); PG8_BAR; PG8_SCHED;
            PG8_LDB(B1, 0, 1); PG8_STAGE(PG8_SB(0, 0), b2, voffB);
            PG8_BAR; PG8_WAIT_L(0); PG8_MMA(0, 1, At, B1); PG8_BAR;
            PG8_LDA(At, 0, 1); PG8_STAGE(PG8_SA(0, 0), a2, voffA);
            PG8_BAR; PG8_WAIT_L(0); PG8_MMA(1, 0, At, B0); PG8_BAR; PG8_SCHED;
            PG8_STAGE(PG8_SB(0, 1), b2 + hstepB, voffB);
            PG8_WAIT_V(6); PG8_BAR; PG8_MMA(1, 1, At, B1); PG8_BAR;
            PG8_LDB(B0, 1, 0); PG8_SCHED; PG8_LDA(At, 1, 0); PG8_STAGE(PG8_SA(0, 1), a2 + hstepA, voffA);
            PG8_WAIT_L(8); PG8_BAR; PG8_WAIT_L(0); PG8_MMA(0, 0, At, B0); PG8_BAR; PG8_SCHED;
            PG8_LDB(B1, 1, 1); PG8_STAGE(PG8_SB(1, 0), b3, voffB);
            PG8_BAR; PG8_WAIT_L(0); PG8_MMA(0, 1, At, B1); PG8_BAR;
            PG8_LDA(At, 1, 1); PG8_STAGE(PG8_SA(1, 0), a3, voffA);
            PG8_BAR; PG8_WAIT_L(0); PG8_MMA(1, 0, At, B0); PG8_BAR; PG8_SCHED;
            PG8_STAGE(PG8_SB(1, 1), b3 + hstepB, voffB);
            PG8_WAIT_V(6); PG8_BAR; PG8_MMA(1, 1, At, B1); PG8_BAR;
            }
        }
        };
        if constexpr (Epi::HAS_MID) { kloop(0, nt >> 1); E.mid(acc, cur, wr, wc, fr, fq); kloop(nt >> 1, nt); }
        else kloop(0, nt);
        if constexpr (ALIGN_EPI) { if (wr == 0) PG8_BAR; }
        E(acc, cur, wr, wc, fr, fq);
        if (!has_next) break;
#pragma unroll
        for (int a = 0; a < 2; ++a)
#pragma unroll
            for (int b = 0; b < 2; ++b)
#pragma unroll
                for (int m = 0; m < 4; ++m)
#pragma unroll
                    for (int n = 0; n < 2; ++n) acc[a][b][m][n] = (f32x4){0.f, 0.f, 0.f, 0.f};
        cur = nxt; cA = nA; cB = nB; ++ui;
        if constexpr (ALIGN_EPI) { if (wr == 1) PG8_BAR; }
    }
    PG8_WAIT_V(0);
    if constexpr (!ALIGN_EPI) { if (wr == 0) PG8_BAR; }
    PG8_BAR;
#undef PG8_SA
#undef PG8_SB
#undef PG8_STAGE
#undef PG8_LDA
#undef PG8_LDB
#undef PG8_MMA
#undef PG8_WAIT_V
#undef PG8_WAIT_L
#undef PG8_BAR
#undef PG8_SCHED
}
}

namespace att {
constexpr int KSL = 12288, VSL = 8192;
constexpr int L_K = 0, L_V = 2 * KSL, L_WS = L_V + 2 * VSL, L_OST = L_WS + 8 * 256, L_END = L_OST + 8 * 4096;
constexpr float THR = 8.f;
__device__ __forceinline__ int crow(int r, int hi) { return (r & 3) + 8 * (r >> 2) + 4 * hi; }
typedef short v4i16_t __attribute__((ext_vector_type(4)));
__device__ __forceinline__ s16x4 vtr(const LAS unsigned char* p) { return __builtin_bit_cast(s16x4, __builtin_amdgcn_ds_read_tr16_b64_v4i16((LAS v4i16_t*)p)); }
#define MX3(a, b, c) __builtin_fmaxf(__builtin_fmaxf((a), (b)), (c))
__device__ __forceinline__ float rowmax(const f32x16& p0, const f32x16& p1) {
    float a = MX3(p0[0], p0[1], p1[0]), b = MX3(p0[2], p0[3], p1[1]); a = MX3(a, p1[2], p1[3]);
#pragma unroll
    for (int r = 4; r < 16; r += 4) { a = MX3(a, p0[r], p0[r + 1]); b = MX3(b, p0[r + 2], p0[r + 3]); a = MX3(a, p1[r], p1[r + 1]); b = MX3(b, p1[r + 2], p1[r + 3]); }
    float m = __builtin_fmaxf(a, b); auto rr = __builtin_amdgcn_permlane32_swap(__float_as_uint(m), __float_as_uint(m), false, false);
    return __builtin_fmaxf(__uint_as_float(rr[0]), __uint_as_float(rr[1]));
}
#undef MX3
__device__ __forceinline__ void cmask(f32x16& p0, f32x16& p1, int jb, int qrel, int hi) {
    const int kb = 64 * jb + 4 * hi;
#pragma unroll
    for (int r = 0; r < 16; ++r) { const int kv = kb + (r & 3) + 8 * (r >> 2); if (kv > qrel) p0[r] = -INFINITY; if (kv + 32 > qrel) p1[r] = -INFINITY; }
}
__device__ __forceinline__ void glds(const void* g, LAS unsigned char* l) { __builtin_amdgcn_global_load_lds((const unsigned*)g, (LAS unsigned*)l, 16, 0, 0); }

__device__ __forceinline__ void attn_unit(int b, int h, int qb, const bf16_t* Q, const bf16_t* KV, const bf16_t* KR, bf16_t* ACAT, LAS unsigned char* lds) {
    const int tid = threadIdx.x, lane = tid & 63, r32 = lane & 31, hi = lane >> 5; const int wid = __builtin_amdgcn_readfirstlane(tid >> 6);
    const size_t rowbase = (size_t)b * SEQ; const int q0 = qb * 256, NT = 4 * qb + 4;
    const bf16_t* Qw = Q + (rowbase + q0 + wid * 32 + r32) * 768 + h * 96 + hi * 8;
    bf16x8 qr[6];
#pragma unroll
    for (int d0 = 0; d0 < 6; ++d0) qr[d0] = *(const bf16x8*)(Qw + d0 * 16);
    const bf16_t* ksrc = KV + (rowbase + lane) * 1024 + h * 128 + wid * 8;
    const bf16_t* rsrc = KR + (rowbase + lane) * 128 + (wid & 3) * 8;
    const bf16_t* vsrc = KV + (rowbase + 16 * (wid & 3) + (lane >> 2)) * 1024 + h * 128 + 64 + (wid >> 2) * 32 + (lane & 3) * 8;
#define ATT_DMA(t, buf) do { glds(ksrc + (size_t)(t) * 64 * 1024, lds + L_K + (buf) * KSL + wid * 1024); \
        if (wid < 4) glds(rsrc + (size_t)(t) * 64 * 128, lds + L_K + (buf) * KSL + (8 + wid) * 1024); \
        glds(vsrc + (size_t)(t) * 64 * 1024, lds + L_V + (buf) * VSL + wid * 1024); } while (0)
    LAS float* wsf = (LAS float*)(lds + L_WS) + wid * 64;
    const int qrel = wid * 32 + r32;
    float mhat = 0.f, l_reg = 0.f; f32x16 o0 = {}, o1 = {};
    ATT_DMA(0, 0);
    for (int t = 0; t < NT; ++t) {
        asm volatile("s_waitcnt vmcnt(0)" ::: "memory");
        __syncthreads();
        if (t + 1 < NT) ATT_DMA(t + 1, (t + 1) & 1);
        const int buf = t & 1;
        const LAS unsigned char* kp = lds + L_K + buf * KSL + hi * 1024 + r32 * 16;
        f32x16 p0 = {}, p1 = {};
#pragma unroll
        for (int d0 = 0; d0 < 6; ++d0) {
            const bf16x8 b0 = *(const LAS bf16x8*)(kp + d0 * 2048), b1 = *(const LAS bf16x8*)(kp + d0 * 2048 + 512);
            p0 = __builtin_amdgcn_mfma_f32_32x32x16_bf16(b0, qr[d0], p0, 0, 0, 0);
            p1 = __builtin_amdgcn_mfma_f32_32x32x16_bf16(b1, qr[d0], p1, 0, 0, 0);
        }
        if (t >= NT - 4) cmask(p0, p1, t - (NT - 4), qrel, hi);
        const float rm = rowmax(p0, p1);
        if (t == 0) mhat = rm;
        else if (__any(rm > mhat + THR)) {
            const float mn = __builtin_fmaxf(mhat, rm), f = __builtin_amdgcn_exp2f(mhat - mn);
            l_reg *= f; mhat = mn;
            if (hi == 0) wsf[r32] = f;
            asm volatile("s_waitcnt lgkmcnt(0)" ::: "memory");
#pragma unroll
            for (int r = 0; r < 16; ++r) { const float fr_ = wsf[crow(r, hi)]; o0[r] *= fr_; o1[r] *= fr_; }
        }
        float sacc = 0.f;
#pragma unroll
        for (int r = 0; r < 16; ++r) { p0[r] = __builtin_amdgcn_exp2f(p0[r] - mhat); p1[r] = __builtin_amdgcn_exp2f(p1[r] - mhat); sacc += p0[r] + p1[r]; }
        l_reg += sacc;
        u32x4 pw[4];
#pragma unroll
        for (int j = 0; j < 4; ++j) { pw[0][j] = cvt_pk_bf16(p0[2 * j], p0[2 * j + 1]); pw[1][j] = cvt_pk_bf16(p0[8 + 2 * j], p0[8 + 2 * j + 1]);
                                      pw[2][j] = cvt_pk_bf16(p1[2 * j], p1[2 * j + 1]); pw[3][j] = cvt_pk_bf16(p1[8 + 2 * j], p1[8 + 2 * j + 1]); }
        const LAS unsigned char* vp = lds + L_V + buf * VSL + ((lane >> 4) & 1) * 32 + (lane & 3) * 8 + (4 * hi + ((lane & 15) >> 2)) * 64;
#pragma unroll
        for (int ks = 0; ks < 4; ++ks) {
            const s16x4 lo0 = vtr(vp + ks * 1024), hi0 = vtr(vp + ks * 1024 + 512), lo1 = vtr(vp + 4096 + ks * 1024), hi1 = vtr(vp + 4096 + ks * 1024 + 512);
            const bf16x8 v0 = (bf16x8){lo0[0], lo0[1], lo0[2], lo0[3], hi0[0], hi0[1], hi0[2], hi0[3]}, v1 = (bf16x8){lo1[0], lo1[1], lo1[2], lo1[3], hi1[0], hi1[1], hi1[2], hi1[3]};
            const bf16x8 pa = __builtin_bit_cast(bf16x8, pw[ks]);
            o0 = __builtin_amdgcn_mfma_f32_32x32x16_bf16(pa, v0, o0, 0, 0, 0);
            o1 = __builtin_amdgcn_mfma_f32_32x32x16_bf16(pa, v1, o1, 0, 0, 0);
        }
    }
#undef ATT_DMA
    { auto rr = __builtin_amdgcn_permlane32_swap(__float_as_uint(l_reg), __float_as_uint(l_reg), false, false); l_reg = __uint_as_float(rr[0]) + __uint_as_float(rr[1]); }
    if (hi == 0) wsf[32 + r32] = l_reg;
    asm volatile("s_waitcnt lgkmcnt(0)" ::: "memory");
    LAS bf16_t* stg = (LAS bf16_t*)(lds + L_OST) + wid * 2048;
#pragma unroll
    for (int r = 0; r < 16; ++r) { const int orow = crow(r, hi); const float rl = __builtin_amdgcn_rcpf(wsf[32 + orow]);
        stg[orow * 64 + r32] = (bf16_t)(cvt_pk_bf16(o0[r] * rl, 0.f) & 0xffffu); stg[orow * 64 + 32 + r32] = (bf16_t)(cvt_pk_bf16(o1[r] * rl, 0.f) & 0xffffu); }
    asm volatile("s_waitcnt lgkmcnt(0)" ::: "memory");
    bf16_t* Ow = ACAT + (rowbase + q0 + wid * 32) * 1024 + h * 64;
#pragma unroll
    for (int i = 0; i < 4; ++i) { const int row = i * 8 + (lane >> 3), ch = lane & 7;
        const u32x4 v = *(const LAS u32x4*)(stg + row * 64 + ch * 8); bf16_t* gp = Ow + (size_t)row * 1024 + ch * 8; const u32x4 gt = *(const u32x4*)gp; u32x4 w;
#pragma unroll
        for (int e = 0; e < 4; ++e) w[e] = cvt_pk_bf16(bflo(v[e]) * bflo(gt[e]), bfhi(v[e]) * bfhi(gt[e]));
        *(u32x4*)gp = w; }
    asm volatile("s_waitcnt lgkmcnt(0)" ::: "memory");
    __syncthreads();
}
}

namespace gla {
constexpr int P = 144;
constexpr int L_QD = 0, L_KD = 9216, L_KDT = 18432, L_VT = 27648, L_ATT = 46080, L_TOT = 55296, L_EB = 57344, L_SSQ = 57600, L_GKL = 59648, L_END = 63744;
__device__ __forceinline__ f32x4 mfma16(bf16x8 a, bf16x8 b, f32x4 c) { return __builtin_amdgcn_mfma_f32_16x16x32_bf16(a, b, c, 0, 0, 0); }
__device__ __forceinline__ float logsig(float x) { return __builtin_fminf(x, 0.f) - __logf(1.f + __expf(-__builtin_fabsf(x))); }

__device__ __forceinline__ void gla_item(int bh, const bf16_t* GQ, const bf16_t* GK, const bf16_t* GV, const bf16_t* SMALL, const float* w_up, const float* b_gk, const float* gnorm, bf16_t* ACAT, LAS unsigned char* lds) {
    const int tid = threadIdx.x, lane = tid & 63, l15 = lane & 15, kg = lane >> 4; const int w = __builtin_amdgcn_readfirstlane(tid >> 6);
    const int b = bh >> 2, h = bh & 3;
    float wup[16];
#pragma unroll
    for (int r = 0; r < 16; ++r) wup[r] = w_up[r * 256 + h * 64 + lane];
    const float bias = b_gk[h * 64 + lane], gn = gnorm[16 * w + l15];
    LAS float* TOT = (LAS float*)(lds + L_TOT); LAS float* EB = (LAS float*)(lds + L_EB); LAS float* SSQ = (LAS float*)(lds + L_SSQ); LAS float* GKL = (LAS float*)(lds + L_GKL);
    f32x4 S[4];
#pragma unroll
    for (int i = 0; i < 4; ++i) S[i] = (f32x4){0.f, 0.f, 0.f, 0.f};
    const int vc = tid & 127, tg2 = tid >> 7;
    for (int n = 0; n < 32; ++n) {
        const size_t row0 = (size_t)b * SEQ + (size_t)n * 64;
        { const int tok = tid >> 3, pr = tid & 7; const unsigned g2 = *(const unsigned*)(SMALL + (row0 + tok) * 128 + 32 + 2 * pr); GKL[tok * 16 + 2 * pr] = bflo(g2); GKL[tok * 16 + 2 * pr + 1] = bfhi(g2); }
        bf16_t qv[8], kv[8], vv[16];
        { const GAS bf16_t* qp = (const GAS bf16_t*)(GQ + (row0 + 8 * w) * 256 + h * 64 + lane); const GAS bf16_t* kp = (const GAS bf16_t*)(GK + (row0 + 8 * w) * 256 + h * 64 + lane); const GAS bf16_t* vp = (const GAS bf16_t*)(GV + (row0 + 16 * tg2) * 512 + h * 128 + vc);
          asm volatile("" : "+v"(qp), "+v"(kp), "+v"(vp));
#pragma unroll
          for (int e = 0; e < 8; ++e) { qv[e] = qp[e * 256]; kv[e] = kp[e * 256]; }
#pragma unroll
          for (int e = 0; e < 16; ++e) vv[e] = vp[e * 512]; }
        __syncthreads();
        float c8[8]; float run = 0.f;
#pragma unroll
        for (int e = 0; e < 8; ++e) {
            const LAS f32x4* gp = (const LAS f32x4*)(GKL + (8 * w + e) * 16); float x = bias;
#pragma unroll
            for (int r4 = 0; r4 < 4; ++r4) { const f32x4 gq4 = gp[r4]; x += gq4[0] * wup[4 * r4] + gq4[1] * wup[4 * r4 + 1] + gq4[2] * wup[4 * r4 + 2] + gq4[3] * wup[4 * r4 + 3]; }
            run += logsig(x) * (1.f / 16.f); c8[e] = run;
        }
        TOT[w * 64 + lane] = run;
        __syncthreads();
        float prefix = 0.f, total = 0.f;
#pragma unroll
        for (int ww = 0; ww < 8; ++ww) { const float tv = TOT[ww * 64 + lane]; total += tv; if (ww < w) prefix += tv; }
        {
            float kd8[8];
#pragma unroll
            for (int e = 0; e < 8; ++e) {
                const float bc = prefix + c8[e], eq = __expf(bc), ek = __expf(-bc), ed = __expf(total - bc);
                const float qf = bf1(qv[e]) * 0.125f * eq, kf = bf1(kv[e]);
                *(LAS bf16_t*)(lds + L_QD + (8 * w + e) * P + lane * 2) = (bf16_t)(cvt_pk_bf16(qf, 0.f) & 0xffffu);
                *(LAS bf16_t*)(lds + L_KD + (8 * w + e) * P + lane * 2) = (bf16_t)(cvt_pk_bf16(kf * ek, 0.f) & 0xffffu);
                kd8[e] = kf * ed;
            }
            u32x4 kw; kw.x = cvt_pk_bf16(kd8[0], kd8[1]); kw.y = cvt_pk_bf16(kd8[2], kd8[3]); kw.z = cvt_pk_bf16(kd8[4], kd8[5]); kw.w = cvt_pk_bf16(kd8[6], kd8[7]);
            *(LAS u32x4*)(lds + L_KDT + lane * P + 16 * w) = kw;
            if (w == 0) EB[lane] = __expf(total);
            u32x4 v0, v1;
            v0.x = (unsigned)vv[0] | ((unsigned)vv[1] << 16); v0.y = (unsigned)vv[2] | ((unsigned)vv[3] << 16); v0.z = (unsigned)vv[4] | ((unsigned)vv[5] << 16); v0.w = (unsigned)vv[6] | ((unsigned)vv[7] << 16);
            v1.x = (unsigned)vv[8] | ((unsigned)vv[9] << 16); v1.y = (unsigned)vv[10] | ((unsigned)vv[11] << 16); v1.z = (unsigned)vv[12] | ((unsigned)vv[13] << 16); v1.w = (unsigned)vv[14] | ((unsigned)vv[15] << 16);
            *(LAS u32x4*)(lds + L_VT + vc * P + 32 * tg2) = v0; *(LAS u32x4*)(lds + L_VT + vc * P + 32 * tg2 + 16) = v1;
        }
        __syncthreads();
        {
            const int mt = w >> 1;
#pragma unroll
            for (int q = 0; q < 2; ++q) {
                const int nt = 2 * (w & 1) + q; f32x4 a = (f32x4){0.f, 0.f, 0.f, 0.f};
                if (nt <= mt) {
#pragma unroll
                    for (int s = 0; s < 2; ++s) { const bf16x8 A = *(const LAS bf16x8*)(lds + L_QD + (16 * mt + l15) * P + 64 * s + 16 * kg), B = *(const LAS bf16x8*)(lds + L_KD + (16 * nt + l15) * P + 64 * s + 16 * kg); a = mfma16(A, B, a); }
                }
#pragma unroll
                for (int r = 0; r < 4; ++r) { const int i = 16 * mt + 4 * kg + r, j = 16 * nt + l15; const float v = (j <= i) ? a[r] : 0.f;
                    *(LAS bf16_t*)(lds + L_ATT + i * P + j * 2) = (bf16_t)(cvt_pk_bf16(v, 0.f) & 0xffffu); }
            }
        }
        __syncthreads();
        f32x4 o[4];
        {
            bf16x8 bv[2], bs[2];
#pragma unroll
            for (int s = 0; s < 2; ++s) { bv[s] = *(const LAS bf16x8*)(lds + L_VT + (16 * w + l15) * P + 64 * s + 16 * kg);
                u32x4 t; t.x = cvt_pk_bf16(S[2 * s][0], S[2 * s][1]); t.y = cvt_pk_bf16(S[2 * s][2], S[2 * s][3]); t.z = cvt_pk_bf16(S[2 * s + 1][0], S[2 * s + 1][1]); t.w = cvt_pk_bf16(S[2 * s + 1][2], S[2 * s + 1][3]); bs[s] = __builtin_bit_cast(bf16x8, t); }
#pragma unroll
            for (int mt = 0; mt < 4; ++mt) {
                f32x4 a = (f32x4){0.f, 0.f, 0.f, 0.f};
#pragma unroll
                for (int s = 0; s < 2; ++s) { const u32x2 lo = *(const LAS u32x2*)(lds + L_QD + (16 * mt + l15) * P + 64 * s + 8 * kg), hi2 = *(const LAS u32x2*)(lds + L_QD + (16 * mt + l15) * P + 64 * s + 32 + 8 * kg);
                    u32x4 t; t.x = lo.x; t.y = lo.y; t.z = hi2.x; t.w = hi2.y; a = mfma16(__builtin_bit_cast(bf16x8, t), bs[s], a); }
#pragma unroll
                for (int s = 0; s < 2; ++s) { const bf16x8 A = *(const LAS bf16x8*)(lds + L_ATT + (16 * mt + l15) * P + 64 * s + 16 * kg); a = mfma16(A, bv[s], a); }
                o[mt] = a;
            }
#pragma unroll
            for (int mt = 0; mt < 4; ++mt) {
                const f32x4 eb4 = *(const LAS f32x4*)(EB + 16 * mt + 4 * kg); f32x4 a = S[mt] * eb4;
#pragma unroll
                for (int s = 0; s < 2; ++s) { const bf16x8 A = *(const LAS bf16x8*)(lds + L_KDT + (16 * mt + l15) * P + 64 * s + 16 * kg); a = mfma16(A, bv[s], a); }
                S[mt] = a;
            }
        }
#pragma unroll
        for (int mt = 0; mt < 4; ++mt)
#pragma unroll
            for (int r = 0; r < 4; ++r) { float s = o[mt][r] * o[mt][r]; s += __shfl_xor(s, 1); s += __shfl_xor(s, 2); s += __shfl_xor(s, 4); s += __shfl_xor(s, 8);
                if (l15 == 0) SSQ[(16 * mt + 4 * kg + r) * 8 + w] = s; }
        __syncthreads();
        GAS bf16_t* gbase = (GAS bf16_t*)(ACAT + (row0 + 4 * kg) * 1024 + 512 + h * 128 + 16 * w + l15); asm volatile("" : "+v"(gbase));
#pragma unroll
        for (int mt = 0; mt < 4; ++mt)
#pragma unroll
            for (int r = 0; r < 4; ++r) { const int tok = 16 * mt + 4 * kg + r; const LAS f32x4* sp = (const LAS f32x4*)(SSQ + tok * 8); const f32x4 a = sp[0], c = sp[1];
                const float tot = ((a[0] + a[1]) + (a[2] + a[3])) + ((c[0] + c[1]) + (c[2] + c[3])); const float rs = rsq(tot * (1.f / 128.f) + EPS);
                GAS bf16_t* gp = gbase + (size_t)(16 * mt + r) * 1024; const float gate = bf1(*gp);
                *gp = (bf16_t)(cvt_pk_bf16(o[mt][r] * rs * gn * gate, 0.f) & 0xffffu); }
    }
    __syncthreads();
}
}

namespace gla2 {
constexpr int WREG = 16384;
constexpr int PA = 144;
typedef short v4i16_t __attribute__((ext_vector_type(4)));
__device__ __forceinline__ s16x4 trr(const LAS unsigned char* p) { return __builtin_bit_cast(s16x4, __builtin_amdgcn_ds_read_tr16_b64_v4i16((LAS v4i16_t*)p)); }
__device__ __forceinline__ bf16x8 cat(s16x4 a, s16x4 b) { return (bf16x8){a[0], a[1], a[2], a[3], b[0], b[1], b[2], b[3]}; }
__device__ __forceinline__ f32x4 mfma16(bf16x8 a, bf16x8 b, f32x4 c) { return __builtin_amdgcn_mfma_f32_16x16x32_bf16(a, b, c, 0, 0, 0); }

__device__ __forceinline__ void g1_wave(int c, const bf16_t* GQ, const bf16_t* GK, const bf16_t* GV, const bf16_t* SMALL, const float* w_up, const float* b_gk,
                                        bf16_t* QDT, bf16_t* KDT, bf16_t* SLOC, float* EBG, LAS unsigned char* wl, int lane) {
    const int bh = c >> 5, n = c & 31, b = bh >> 2, h = bh & 3, l15 = lane & 15, kg = lane >> 4;
    const size_t row0 = (size_t)b * SEQ + (size_t)n * 64;
    LAS unsigned char* AR = wl; LAS unsigned char* VR = wl + 9216; LAS float* GKL = (LAS float*)(wl + 9216);
    { const u32x4* sp = (const u32x4*)(SMALL + (row0 + lane) * 128 + 32); const u32x4 g0 = sp[0], g1 = sp[1];
      LAS f32x4* gp = (LAS f32x4*)(GKL + lane * 16);
      gp[0] = (f32x4){bflo(g0[0]), bfhi(g0[0]), bflo(g0[1]), bfhi(g0[1])}; gp[1] = (f32x4){bflo(g0[2]), bfhi(g0[2]), bflo(g0[3]), bfhi(g0[3])};
      gp[2] = (f32x4){bflo(g1[0]), bfhi(g1[0]), bflo(g1[1]), bfhi(g1[1])}; gp[3] = (f32x4){bflo(g1[2]), bfhi(g1[2]), bflo(g1[3]), bfhi(g1[3])}; }
    u32x4 qld[8], kld[8];
#pragma unroll
    for (int i = 0; i < 8; ++i) { const int idx = i * 64 + lane, tok = idx >> 3, d8 = idx & 7; const size_t o = (row0 + tok) * 256 + h * 64 + d8 * 8; qld[i] = *(const u32x4*)(GQ + o); kld[i] = *(const u32x4*)(GK + o); }
    float wup[16];
#pragma unroll
    for (int r = 0; r < 16; ++r) wup[r] = w_up[r * 256 + h * 64 + lane];
    const float bias = b_gk[h * 64 + lane];
    float bc[64]; float run = 0.f;
#pragma unroll
    for (int t = 0; t < 64; ++t) {
        const LAS f32x4* gp = (const LAS f32x4*)(GKL + t * 16); float x = bias;
#pragma unroll
        for (int r4 = 0; r4 < 4; ++r4) { const f32x4 g4 = gp[r4]; x += g4[0] * wup[4 * r4] + g4[1] * wup[4 * r4 + 1] + g4[2] * wup[4 * r4 + 2] + g4[3] * wup[4 * r4 + 3]; }
        const float ls2 = __builtin_fminf(x, 0.f) * LOG2E - __builtin_amdgcn_logf(1.f + __builtin_amdgcn_exp2f(-LOG2E * __builtin_fabsf(x)));
        run += ls2 * (1.f / 16.f); bc[t] = run;
    }
    const float etot = __builtin_amdgcn_exp2f(run);
#pragma unroll
    for (int i = 0; i < 8; ++i) { const int idx = i * 64 + lane, tok = idx >> 3, d8 = idx & 7; *(LAS u32x4*)(AR + tok * PA + d8 * 16) = qld[i]; }
    {
        unsigned pk[32];
#pragma unroll
        for (int t = 0; t < 64; t += 2) {
            const float q0 = bf1(*(const LAS bf16_t*)(AR + t * PA + lane * 2)), q1 = bf1(*(const LAS bf16_t*)(AR + (t + 1) * PA + lane * 2));
            pk[t >> 1] = cvt_pk_bf16(q0 * 0.125f * __builtin_amdgcn_exp2f(bc[t]), q1 * 0.125f * __builtin_amdgcn_exp2f(bc[t + 1]));
        }
        u32x4* dst = (u32x4*)(QDT + (size_t)c * 4096 + lane * 64);
#pragma unroll
        for (int i = 0; i < 8; ++i) dst[i] = (u32x4){pk[4 * i], pk[4 * i + 1], pk[4 * i + 2], pk[4 * i + 3]};
    }
#pragma unroll
    for (int i = 0; i < 8; ++i) { const int idx = i * 64 + lane, tok = idx >> 3, d8 = idx & 7; *(LAS u32x4*)(AR + tok * PA + d8 * 16) = kld[i]; }
    {
        unsigned pk[32], pd[32];
#pragma unroll
        for (int t = 0; t < 64; t += 2) {
            const float k0 = bf1(*(const LAS bf16_t*)(AR + t * PA + lane * 2)), k1 = bf1(*(const LAS bf16_t*)(AR + (t + 1) * PA + lane * 2));
            const float e0 = __builtin_amdgcn_exp2f(-bc[t]), e1 = __builtin_amdgcn_exp2f(-bc[t + 1]);
            pk[t >> 1] = cvt_pk_bf16(k0 * e0, k1 * e1); pd[t >> 1] = cvt_pk_bf16(k0 * e0 * etot, k1 * e1 * etot);
        }
        u32x4* dst = (u32x4*)(KDT + (size_t)c * 4096 + lane * 64);
#pragma unroll
        for (int i = 0; i < 8; ++i) dst[i] = (u32x4){pk[4 * i], pk[4 * i + 1], pk[4 * i + 2], pk[4 * i + 3]};
#pragma unroll
        for (int i = 0; i < 8; ++i) *(LAS u32x4*)(AR + lane * PA + i * 16) = (u32x4){pd[4 * i], pd[4 * i + 1], pd[4 * i + 2], pd[4 * i + 3]};
    }
    EBG[(size_t)c * 64 + lane] = etot;
    bf16x8 af[4][2];
#pragma unroll
    for (int mt = 0; mt < 4; ++mt)
#pragma unroll
        for (int s2 = 0; s2 < 2; ++s2) af[mt][s2] = *(const LAS bf16x8*)(AR + (16 * mt + l15) * PA + 64 * s2 + 16 * kg);
#pragma unroll 1
    for (int vs = 0; vs < 4; ++vs) {
        u32x4 vld[4];
#pragma unroll
        for (int i = 0; i < 4; ++i) { const int idx = i * 64 + lane, tok = idx >> 2, c4 = idx & 3; vld[i] = *(const u32x4*)(GV + (row0 + tok) * 512 + h * 128 + vs * 32 + c4 * 8); }
#pragma unroll
        for (int i = 0; i < 4; ++i) { const int idx = i * 64 + lane, tok = idx >> 2, c4 = idx & 3; *(LAS u32x4*)(VR + tok * 80 + c4 * 16) = vld[i]; }
#pragma unroll
        for (int nt2 = 0; nt2 < 2; ++nt2) {
            bf16x8 bv[2];
#pragma unroll
            for (int s2 = 0; s2 < 2; ++s2) { const LAS unsigned char* vp = VR + (32 * s2 + 8 * kg + (l15 >> 2)) * 80 + nt2 * 32 + (l15 & 3) * 8; bv[s2] = cat(trr(vp), trr(vp + 4 * 80)); }
            bf16_t* dst = SLOC + (((size_t)c * 8 + vs * 2 + nt2) * 64 + lane) * 16; unsigned pw[8];
#pragma unroll
            for (int mt = 0; mt < 4; ++mt) { f32x4 a = (f32x4){0.f, 0.f, 0.f, 0.f}; a = mfma16(af[mt][0], bv[0], a); a = mfma16(af[mt][1], bv[1], a); pw[2 * mt] = cvt_pk_bf16(a[0], a[1]); pw[2 * mt + 1] = cvt_pk_bf16(a[2], a[3]); }
            *(u32x4*)dst = (u32x4){pw[0], pw[1], pw[2], pw[3]}; *(u32x4*)(dst + 8) = (u32x4){pw[4], pw[5], pw[6], pw[7]};
        }
    }
}

__device__ __forceinline__ void g2_thread(int gid, const bf16_t* SLOC, const float* EBG, bf16_t* SN) {
    const int bh = gid >> 11, rem = gid & 2047, nt = rem >> 8, ln = (rem >> 2) & 63, mt = rem & 3, dk0 = 16 * mt + 4 * (ln >> 4);
    f32x4 st = (f32x4){0.f, 0.f, 0.f, 0.f};
#pragma unroll 8
    for (int n = 0; n < 32; ++n) {
        const size_t c = (size_t)bh * 32 + n; const size_t e = ((c * 8 + nt) * 64 + ln) * 16 + mt * 4;
        u32x2 w; w.x = cvt_pk_bf16(st[0], st[1]); w.y = cvt_pk_bf16(st[2], st[3]); *(u32x2*)(SN + e) = w;
        const u32x2 slw = *(const u32x2*)(SLOC + e); const f32x4 sl = (f32x4){bflo(slw.x), bfhi(slw.x), bflo(slw.y), bfhi(slw.y)}, eb = *(const f32x4*)(EBG + c * 64 + dk0);
        st = st * eb + sl;
    }
}

__device__ __forceinline__ void g3_wave(int c, const bf16_t* QDT, const bf16_t* KDT, const bf16_t* GV, const bf16_t* SN, const float* gnorm, bf16_t* ACAT, LAS unsigned char* wl, int lane) {
    const int bh = c >> 5, n = c & 31, b = bh >> 2, h = bh & 3, l15 = lane & 15, kg = lane >> 4;
    const size_t row0 = (size_t)b * SEQ + (size_t)n * 64;
    u32x4 ql[8], kl[8];
#pragma unroll
    for (int i = 0; i < 8; ++i) { ql[i] = *(const u32x4*)(QDT + (size_t)c * 4096 + (size_t)(i * 64 + lane) * 8); kl[i] = *(const u32x4*)(KDT + (size_t)c * 4096 + (size_t)(i * 64 + lane) * 8); }
    const int fro = (4 * kg + (l15 >> 2)) * PA + (l15 & 3) * 8;
    bf16x8 qf[4][2], kf[4][2];
#pragma unroll
    for (int i = 0; i < 8; ++i) { const int idx = i * 64 + lane, d = idx >> 3, t8 = idx & 7; *(LAS u32x4*)(wl + d * PA + t8 * 16) = ql[i]; }
#pragma unroll
    for (int it = 0; it < 4; ++it)
#pragma unroll
        for (int s2 = 0; s2 < 2; ++s2) { const LAS unsigned char* p = wl + fro + (32 * s2) * PA + it * 32; qf[it][s2] = cat(trr(p), trr(p + 16 * PA)); }
#pragma unroll
    for (int i = 0; i < 8; ++i) { const int idx = i * 64 + lane, d = idx >> 3, t8 = idx & 7; *(LAS u32x4*)(wl + d * PA + t8 * 16) = kl[i]; }
#pragma unroll
    for (int jt = 0; jt < 4; ++jt)
#pragma unroll
        for (int s2 = 0; s2 < 2; ++s2) { const LAS unsigned char* p = wl + fro + (32 * s2) * PA + jt * 32; kf[jt][s2] = cat(trr(p), trr(p + 16 * PA)); }
    u32x4 sf[8][2];
#pragma unroll
    for (int nt = 0; nt < 8; ++nt) { const u32x4* sp = (const u32x4*)(SN + (((size_t)c * 8 + nt) * 64 + lane) * 16); sf[nt][0] = sp[0]; sf[nt][1] = sp[1]; }
    u32x4 ab[4][2];
#pragma unroll
    for (int it = 0; it < 4; ++it) {
        f32x4 at[4];
#pragma unroll
        for (int jt = 0; jt < 4; ++jt) {
            at[jt] = (f32x4){0.f, 0.f, 0.f, 0.f};
            if (jt <= it) { at[jt] = mfma16(kf[jt][0], qf[it][0], at[jt]); at[jt] = mfma16(kf[jt][1], qf[it][1], at[jt]); }
            if (jt == it) {
#pragma unroll
                for (int r = 0; r < 4; ++r) if (4 * kg + r > l15) at[jt][r] = 0.f;
            }
        }
#pragma unroll
        for (int s2 = 0; s2 < 2; ++s2) { ab[it][s2].x = cvt_pk_bf16(at[2 * s2][0], at[2 * s2][1]); ab[it][s2].y = cvt_pk_bf16(at[2 * s2][2], at[2 * s2][3]); ab[it][s2].z = cvt_pk_bf16(at[2 * s2 + 1][0], at[2 * s2 + 1][1]); ab[it][s2].w = cvt_pk_bf16(at[2 * s2 + 1][2], at[2 * s2 + 1][3]); }
    }
    {
        u32x4 vl[16];
#pragma unroll
        for (int i = 0; i < 16; ++i) { const int idx = i * 64 + lane, tok = idx >> 4, c16 = idx & 15; vl[i] = *(const u32x4*)(GV + (row0 + tok) * 512 + h * 128 + c16 * 8); }
#pragma unroll
        for (int i = 0; i < 16; ++i) { const int idx = i * 64 + lane, tok = idx >> 4, c16 = idx & 15; *(LAS u32x4*)(wl + tok * 256 + ((c16 ^ ((tok & 7) << 1)) * 16)) = vl[i]; }
    }
    const int vrow = 4 * kg + (l15 >> 2), vx = vrow & 7;
    const LAS unsigned char* vbase = wl + vrow * 256 + (l15 & 3) * 8;
#pragma unroll 1
    for (int it = 0; it < 4; ++it) {
        f32x4 o[8]; float ssq = 0.f;
#pragma unroll
        for (int nt = 0; nt < 8; ++nt) {
            f32x4 a = (f32x4){0.f, 0.f, 0.f, 0.f};
            a = mfma16(__builtin_bit_cast(bf16x8, sf[nt][0]), qf[it][0], a); a = mfma16(__builtin_bit_cast(bf16x8, sf[nt][1]), qf[it][1], a);
            const LAS unsigned char* vp = vbase + ((nt ^ vx) * 32);
            { const bf16x8 v0 = cat(trr(vp), trr(vp + 16 * 256)); a = mfma16(v0, __builtin_bit_cast(bf16x8, ab[it][0]), a); }
            if (it >= 2) { const bf16x8 v1 = cat(trr(vp + 32 * 256), trr(vp + 48 * 256)); a = mfma16(v1, __builtin_bit_cast(bf16x8, ab[it][1]), a); }
            o[nt] = a; ssq += (a[0] * a[0] + a[1] * a[1]) + (a[2] * a[2] + a[3] * a[3]);
        }
        ssq += __shfl_xor(ssq, 16); ssq += __shfl_xor(ssq, 32);
        const float rs = rsq(ssq * (1.f / 128.f) + EPS);
        bf16_t* gp = ACAT + (row0 + 16 * it + l15) * 1024 + 512 + h * 128 + 4 * kg;
#pragma unroll
        for (int nt = 0; nt < 8; ++nt) {
            const f32x4 gn = *(const f32x4*)(gnorm + 16 * nt + 4 * kg); const u32x2 gt = *(const u32x2*)(gp + 16 * nt);
            u32x2 w; w.x = cvt_pk_bf16(o[nt][0] * rs * gn[0] * bflo(gt.x), o[nt][1] * rs * gn[1] * bfhi(gt.x)); w.y = cvt_pk_bf16(o[nt][2] * rs * gn[2] * bflo(gt.y), o[nt][3] * rs * gn[3] * bfhi(gt.y));
            *(u32x2*)(gp + 16 * nt) = w;
        }
    }
}
}

constexpr int NWAVES = 8;
#ifndef PROBE_G
#define PROBE_G 0
#endif
#ifndef PROBE_DUP
#define PROBE_DUP 0
#endif
#ifndef PHMASK
#define PHMASK 0x7ff
#endif
constexpr size_t MiB = 1u << 20;
constexpr size_t WS_CTL = 0, CTL_ZERO_BYTES = 1 * MiB;
constexpr size_t WS_WIN = 2 * MiB, WS_WUQ = 12 * MiB, WS_WUKV = 13 * MiB, WS_WCAT = 14 * MiB, WS_WOUT = 16 * MiB, WS_WPLE = 18 * MiB, WS_WPLEG = 19 * MiB;
constexpr size_t WS_ROPE = 22 * MiB, WS_SSQA = 26 * MiB, WS_SSQ1 = 30 * MiB, WS_SSQE = 32 * MiB, WS_SSQ2 = 34 * MiB;
constexpr size_t WS_PB = 36 * MiB, WS_ACAT = 52 * MiB, WS_SMA = 116 * MiB, WS_SMB = 180 * MiB;
constexpr size_t WS_S1 = 244 * MiB;
constexpr size_t WS_S2 = 308 * MiB;
constexpr size_t WS_S3 = 372 * MiB;
constexpr size_t WS_Q = 444 * MiB, WS_END = 492 * MiB;
constexpr size_t WS_H = WS_S1, WS_KV = WS_S1, WS_MERGED = WS_S1;
constexpr size_t WS_CQ = WS_S2, WS_CKV = WS_S2 + 24 * MiB, WS_X1B = WS_S2;
constexpr size_t WS_GQ = WS_S3, WS_GK = WS_S3 + 16 * MiB, WS_GV = WS_S3 + 32 * MiB, WS_SMALL = WS_S3 + 64 * MiB, WS_E = WS_S3;
constexpr int CW_BAR = 4096;
constexpr int CW_Q = 16384;
constexpr int RING_OFF = 0, RING_BYTES = 131072;
constexpr int LDSCTL_OFF = RING_BYTES, MISC_OFF = LDSCTL_OFF + 320;
constexpr int LDS_BYTES = 147456;
static_assert(att::L_END <= RING_BYTES && gla::L_END <= RING_BYTES && MISC_OFF + 128 <= LDS_BYTES, "LDS map");

typedef GAS unsigned gu32;
#define RLX_AGENT __ATOMIC_RELAXED, __HIP_MEMORY_SCOPE_AGENT
#define LDS_WAIT() asm volatile("s_waitcnt lgkmcnt(0)" ::: "memory")
#define VM_WAIT() asm volatile("s_waitcnt vmcnt(0)" ::: "memory")

#define XB_TMO      128
#define XB_XCNT(j)  (256  + 64 * (j))
#define XB_XSUB(j)  (1280 + 64 * (j))
#define XB_XGEN(j)  (2304 + 64 * (j))
#define XB_TOP      3328
#define XB_TOPGEN   3392
#define XCD_BAR_WORDS 3456
#define XB_SPIN_CAP (1u << 18)
__device__ __forceinline__ unsigned xb_ld(unsigned* p)              { return __hip_atomic_load(p, __ATOMIC_RELAXED, __HIP_MEMORY_SCOPE_AGENT); }
__device__ __forceinline__ unsigned xb_add(unsigned* p, unsigned v) { return __hip_atomic_fetch_add(p, v, __ATOMIC_RELAXED, __HIP_MEMORY_SCOPE_AGENT); }
__device__ __forceinline__ unsigned xb_xcc_id() { return (unsigned)__builtin_amdgcn_s_getreg((3 << 11) | 20) & 0xFu; }
#define XB_SPIN(cond, bar) do { unsigned _sp = 0; while (cond) { __builtin_amdgcn_s_sleep(1); \
    if ((++_sp & 255u) == 0u) { if (xb_ld(&(bar)[XB_TMO])) break; if (_sp > XB_SPIN_CAP) { atomicAdd(&(bar)[XB_TMO], 1u); break; } } } } while (0)
struct XcdBarrier { unsigned* bar; unsigned x; volatile LAS unsigned* st; };
__device__ __forceinline__ XcdBarrier xcd_barrier_post(unsigned* bar, volatile LAS unsigned* st) {
    XcdBarrier b; b.bar = bar; b.x = xb_xcc_id(); b.st = st;
    if (threadIdx.x == 0) (void)xb_add(&bar[XB_XCNT(b.x)], 1u);
    return b;
}
__device__ __forceinline__ void xcd_barrier_complete(unsigned* bar, unsigned x, unsigned& nloc, unsigned& nx) {
    const unsigned G = gridDim.x * gridDim.y * gridDim.z;
    unsigned sum, cnt, mine, sp = 0u;
    for (;;) {
        sum = 0u; cnt = 0u; mine = 0u;
#pragma unroll
        for (unsigned j = 0; j < 16; ++j) { const unsigned c = xb_ld(&bar[XB_XCNT(j)]); sum += c; cnt += (c > 0u) ? 1u : 0u; mine = (j == x) ? c : mine; }
        if (sum == G) break;
        __builtin_amdgcn_s_sleep(1);
        if ((++sp & 255u) == 0u) { if (xb_ld(&bar[XB_TMO])) break; if (sp > XB_SPIN_CAP) { atomicAdd(&bar[XB_TMO], 1u); break; } }
    }
    nloc = mine > 0u ? mine : 1u; nx = cnt > 0u ? cnt : 1u;
}
__device__ __forceinline__ void xcd_barrier(const XcdBarrier& b) {
    asm volatile("s_waitcnt vmcnt(0)" ::: "memory");
    __syncthreads();
    if (threadIdx.x == 0) {
        unsigned* bar = b.bar;
        __builtin_amdgcn_s_waitcnt(0);
        unsigned nloc = b.st[0], nx = b.st[1];
        if (nloc == 0u) { xcd_barrier_complete(bar, b.x, nloc, nx); b.st[0] = nloc; b.st[1] = nx; }
        const unsigned old = xb_add(&bar[XB_XSUB(b.x)], 1u);
        const unsigned gen = old / nloc;
        if (old + 1u == (gen + 1u) * nloc) {
            __builtin_amdgcn_fence(__ATOMIC_RELEASE, "agent");
            asm volatile("s_waitcnt vmcnt(0)" ::: "memory");
            const unsigned og = xb_add(&bar[XB_TOP], 1u);
            const unsigned tg = og / nx;
            if (og + 1u == (tg + 1u) * nx) xb_add(&bar[XB_TOPGEN], 1u);
            else XB_SPIN(xb_ld(&bar[XB_TOPGEN]) == tg, bar);
            __builtin_amdgcn_fence(__ATOMIC_ACQUIRE, "agent");
            xb_add(&bar[XB_XGEN(b.x)], 1u);
            asm volatile("s_waitcnt vmcnt(0)" ::: "memory");
        } else {
            XB_SPIN(xb_ld(&bar[XB_XGEN(b.x)]) == gen, bar);
            __builtin_amdgcn_fence(__ATOMIC_ACQUIRE, "agent");
            asm volatile("s_waitcnt vmcnt(0)" ::: "memory");
        }
    }
    __syncthreads();
}

__device__ __forceinline__ float wave_sum(float v) {
#pragma unroll
    for (int o = 1; o < 64; o <<= 1) v += __shfl_xor(v, o);
    return v;
}
__device__ __forceinline__ int rope_pinv(int i) { return (i < 16) ? (8 * (i >> 2) + (i & 3)) : (8 * ((i - 16) >> 2) + 4 + (i & 3)); }
__device__ __forceinline__ int map_win(int n) {
    if (n < 384) return n;
    if (n < 640) return n;
    if (n < 672) return 4736 + rope_pinv(n - 640);
    if (n < 1184) return 1664 + (n - 672);
    if (n < 1440) return 640 + (n - 1184);
    if (n < 1696) return 896 + (n - 1440);
    if (n < 2208) return 1152 + (n - 1696);
    if (n < 2224) return 4768 + (n - 2208);
    if (n < 2736) return 2176 + (n - 2224);
    if (n < 3760) return 2688 + (n - 2736);
    return 3712 + (n - 3760);
}
__device__ __forceinline__ int map_wuq(int n) { const int hh = n / 96, r = n % 96; return (r < 64) ? n : hh * 96 + 64 + rope_pinv(r - 64); }
template <int MAP> __device__ __forceinline__ void p0_transpose_item(const float* W, int K, int N, bf16_t* WT, int ldk, int kcol_off, const float* gain, LAS float* scr, int item, int lane) {
    const int nblk = (N + 31) / 32, kb = item / nblk, nb = item % nblk, k0 = 64 * kb, n0 = 32 * nb;
    const bool inb = (n0 + (lane & 31)) < N;
#pragma unroll 8
    for (int i = 0; i < 32; ++i) { const int kk = 2 * i + (lane >> 5); float v = inb ? W[(size_t)(k0 + kk) * N + n0 + (lane & 31)] : 0.f; if (gain) v *= gain[k0 + kk]; scr[kk * 33 + (lane & 31)] = v; }
    LDS_WAIT(); asm volatile("" ::: "memory");
    const int c = lane & 7;
#pragma unroll
    for (int j = 0; j < 4; ++j) { const int n = (lane >> 3) + 8 * j; const LAS float* s = scr + (8 * c) * 33 + n;
        u32x4 o; o.x = cvt_pk_bf16(s[0 * 33], s[1 * 33]); o.y = cvt_pk_bf16(s[2 * 33], s[3 * 33]); o.z = cvt_pk_bf16(s[4 * 33], s[5 * 33]); o.w = cvt_pk_bf16(s[6 * 33], s[7 * 33]);
        const int ns = n0 + n;
        if (ns < N) { const int nd = (MAP == 1) ? map_win(ns) : (MAP == 2) ? map_wuq(ns) : ns; *(GAS u32x4*)(WT + (size_t)nd * ldk + kcol_off + k0 + 8 * c) = o; } }
    LDS_WAIT(); asm volatile("" ::: "memory");
}

__device__ const float ROPE_INVF[16] = {1.0f, 0.5623413324356079f, 0.3162277638912201f, 0.17782793939113617f, 0.10000000149011612f, 0.05623412877321243f, 0.03162277862429619f, 0.017782794311642647f,
    0.009999999776482582f, 0.005623413249850273f, 0.003162277862429619f, 0.0017782794311642647f, 0.0010000000474974513f, 0.000562341301701963f, 0.0003162277862429619f, 0.00017782794020604342f};

struct Args { const void* in[20]; float* out; unsigned char* ws; };
#define IN_F(k) ((const float*)args.in[k])
#define WSB(off) ((bf16_t*)(args.ws + (off)))
#define WSF(off) ((float*)(args.ws + (off)))


__global__ void __launch_bounds__(NWAVES * 64, 2) hybrid_fwd(Args args) {
    extern __shared__ __attribute__((aligned(16))) unsigned char lds_raw[];
    LAS unsigned char* lds = (LAS unsigned char*)lds_raw;
    volatile LAS unsigned* MISC = (volatile LAS unsigned*)(lds + MISC_OFF);
    const int tid0 = threadIdx.x, wave = __builtin_amdgcn_readfirstlane(tid0 >> 6);
    const int G = gridDim.x; const int bx = blockIdx.x; const int vcu = (G % 8 == 0) ? (bx % 8) * (G / 8) + bx / 8 : bx;
    gu32* ctl = (gu32*)(args.ws + WS_CTL);
    for (int u = tid0; u < (LDS_BYTES - LDSCTL_OFF) / 4; u += NWAVES * 64) ((LAS unsigned*)(lds + LDSCTL_OFF))[u] = 0u;
    __syncthreads();
    XcdBarrier bar = xcd_barrier_post((unsigned*)(ctl + CW_BAR), MISC + 8);
#define GRID_BAR() xcd_barrier(bar)
#define PHASE_IDS() int tid = threadIdx.x; asm volatile("" : "+v"(tid)); const int lane = tid & 63; (void)lane

    if (PHMASK & 1) {
        PHASE_IDS();
        LAS float* scr = (LAS float*)(lds + RING_OFF + wave * 16384);
        const int gw = vcu * NWAVES + wave, NGW = G * NWAVES;
        constexpr int I_IN = (1024 / 64) * ((NIN_REAL + 31) / 32), I_UQ = (384 / 64) * (768 / 32), I_UKV = (256 / 64) * (1024 / 32), I_BR = (512 / 64) * (1024 / 32),
                      I_OUT = (1024 / 64) * (1024 / 32), I_PLE = (256 / 64) * (1024 / 32), I_PLEG = I_OUT;
        constexpr int NITEMS = I_IN + I_UQ + I_UKV + 2 * I_BR + I_OUT + I_PLE + I_PLEG;
        for (int it = gw; it < NITEMS; it += NGW) {
            int r = it;
            if (r < I_IN) { p0_transpose_item<1>(IN_F(4), 1024, NIN_REAL, WSB(WS_WIN), 1024, 0, nullptr, scr, r, lane); continue; } r -= I_IN;
            if (r < I_UQ) { p0_transpose_item<2>(IN_F(6), 384, 768, WSB(WS_WUQ), 384, 0, IN_F(5), scr, r, lane); continue; } r -= I_UQ;
            if (r < I_UKV) { p0_transpose_item<0>(IN_F(8), 256, 1024, WSB(WS_WUKV), 256, 0, IN_F(7), scr, r, lane); continue; } r -= I_UKV;
            if (r < I_BR) { p0_transpose_item<0>(IN_F(12), 512, 1024, WSB(WS_WCAT), 1024, 0, nullptr, scr, r, lane); continue; } r -= I_BR;
            if (r < I_BR) { p0_transpose_item<0>(IN_F(13), 512, 1024, WSB(WS_WCAT), 1024, 512, nullptr, scr, r, lane); continue; } r -= I_BR;
            if (r < I_OUT) { p0_transpose_item<0>(IN_F(14), 1024, 1024, WSB(WS_WOUT), 1024, 0, nullptr, scr, r, lane); continue; } r -= I_OUT;
            if (r < I_PLE) { p0_transpose_item<0>(IN_F(15), 256, 1024, WSB(WS_WPLE), 256, 0, nullptr, scr, r, lane); continue; } r -= I_PLE;
            p0_transpose_item<0>(IN_F(18), 1024, 1024, WSB(WS_WPLEG), 1024, 0, IN_F(17), scr, r, lane);
        }
        { const int gt = vcu * (NWAVES * 64) + tid, NT_ = G * NWAVES * 64; const int npad = (NIN - NIN_REAL) * 1024 / 8; bf16_t* W_IN = WSB(WS_WIN);
          for (int i = gt; i < npad; i += NT_) *(GAS u32x4*)(W_IN + (size_t)NIN_REAL * 1024 + (size_t)i * 8) = (u32x4){0u, 0u, 0u, 0u}; }
        { const float* x = IN_F(0); const float* p_in = IN_F(1); const float* norm_in_g = IN_F(3); bf16_t* HB = WSB(WS_H); bf16_t* PB = WSB(WS_PB);
        f32x4 gg[4];
#pragma unroll
        for (int j = 0; j < 4; ++j) gg[j] = *((const GAS f32x4*)norm_in_g + lane + 64 * j);
        for (int m0 = gw * 4; m0 < M; m0 += NGW * 4) {
            f32x4 v[4][4], pv[4];
#pragma unroll
            for (int r = 0; r < 4; ++r) { const GAS f32x4* xr = (const GAS f32x4*)(x + (size_t)(m0 + r) * D) + lane;
#pragma unroll
                for (int j = 0; j < 4; ++j) v[r][j] = xr[64 * j];
                pv[r] = *((const GAS f32x4*)(p_in + (size_t)(m0 + r) * 256) + lane); }
#pragma unroll
            for (int r = 0; r < 4; ++r) {
                float s2 = 0.f;
#pragma unroll
                for (int j = 0; j < 4; ++j) s2 += (v[r][j][0] * v[r][j][0] + v[r][j][1] * v[r][j][1]) + (v[r][j][2] * v[r][j][2] + v[r][j][3] * v[r][j][3]);
                const float rs = rsq(wave_sum(s2) * (1.f / D) + EPS);
                GAS u32x2* o8 = (GAS u32x2*)(HB + (size_t)(m0 + r) * D) + lane;
#pragma unroll
                for (int j = 0; j < 4; ++j) { u32x2 w2; w2.x = cvt_pk_bf16(v[r][j][0] * rs * gg[j][0], v[r][j][1] * rs * gg[j][1]); w2.y = cvt_pk_bf16(v[r][j][2] * rs * gg[j][2], v[r][j][3] * rs * gg[j][3]); o8[64 * j] = w2; }
                u32x2 pw; pw.x = cvt_pk_bf16(pv[r][0], pv[r][1]); pw.y = cvt_pk_bf16(pv[r][2], pv[r][3]); *((GAS u32x2*)(PB + (size_t)(m0 + r) * 256) + lane) = pw;
            }
        } }
        { const int gt = vcu * (NWAVES * 64) + tid, NT_ = G * NWAVES * 64; const int* positions = (const int*)args.in[2]; float* ROPE = WSF(WS_ROPE);
          for (int i = gt; i < M * 16; i += NT_) { const int m = i >> 4, k = i & 15; const float ang = (float)positions[m] * ROPE_INVF[k];
              const double rev = (double)ang * 0.15915494309189535; const double fr = rev - __builtin_rint(rev); const float f = (float)fr;
              ROPE[2 * (size_t)i] = __builtin_amdgcn_cosf(f); ROPE[2 * (size_t)i + 1] = __builtin_amdgcn_sinf(f); } }
    }
    GRID_BAR();

    if (PHMASK & 2) {
        pg8::Gemm g{WSB(WS_H), WSB(WS_WIN), M, NIN, 1024, 1024}; pg8::StaticOrder S; S.init(M, NIN, G, bx);
        pg8::EpiProj E{WSB(WS_CQ), WSB(WS_CKV), WSB(WS_GQ), WSB(WS_GK), WSB(WS_GV), WSB(WS_ACAT), WSB(WS_SMA), WSB(WS_SMB), WSB(WS_SMALL), WSF(WS_SSQA), WSF(WS_ROPE)};
        pg8::gemm_phase<pg8::EpiProj, pg8::StaticOrder, true, true>(lds + RING_OFF, g, S, E);
    }
    GRID_BAR();

    if (PROBE_DUP & 2) {
        pg8::Gemm g{WSB(WS_H), WSB(WS_WIN), M, NIN, 1024, 1024}; pg8::StaticOrder S; S.init(M, NIN, G, bx);
        pg8::EpiProj E{WSB(WS_CQ), WSB(WS_CKV), WSB(WS_GQ), WSB(WS_GK), WSB(WS_GV), WSB(WS_ACAT), WSB(WS_SMA), WSB(WS_SMB), WSB(WS_SMALL), WSF(WS_SSQA), WSF(WS_ROPE)};
        pg8::gemm_phase<pg8::EpiProj, pg8::StaticOrder, true, true>(lds + RING_OFF, g, S, E);
        GRID_BAR();
    }
    {
        PHASE_IDS();
        bf16_t* gsc = (bf16_t*)args.out;
        for (int c = bx * NWAVES + wave; c < 2048; c += G * NWAVES)
            gla2::g1_wave(c, WSB(WS_GQ), WSB(WS_GK), WSB(WS_GV), WSB(WS_SMALL), IN_F(9), IN_F(10), gsc + 32 * MiB, gsc + 40 * MiB, gsc, WSF(WS_SSQ1), lds + RING_OFF + wave * gla2::WREG, lane);
        __syncthreads();
        if (PROBE_G & 1) { for (int c = bx * NWAVES + wave; c < 2048; c += G * NWAVES)
            gla2::g1_wave(c, WSB(WS_GQ), WSB(WS_GK), WSB(WS_GV), WSB(WS_SMALL), IN_F(9), IN_F(10), gsc + 32 * MiB, gsc + 40 * MiB, gsc, WSF(WS_SSQ1), lds + RING_OFF + wave * gla2::WREG, lane);
            __syncthreads(); }
    }
    if (PHMASK & 4) {
        pg8::Gemm g{WSB(WS_CQ), WSB(WS_WUQ), M, 768, 384, 384}; pg8::StaticOrder S; S.init(M, 768, G, bx);
        pg8::EpiQ E{WSB(WS_Q), WSF(WS_SSQA), WSF(WS_ROPE)};
        pg8::gemm_phase<pg8::EpiQ, pg8::StaticOrder, true, true>(lds + RING_OFF, g, S, E);
    }
    if (PHMASK & 8) {
        pg8::Gemm g{WSB(WS_CKV), WSB(WS_WUKV), M, 1024, 256, 256}; pg8::StaticOrder S; S.init(M, 1024, G, bx);
        pg8::EpiKV E{WSB(WS_KV), WSF(WS_SSQA)};
        pg8::gemm_phase<pg8::EpiKV, pg8::StaticOrder, true, true>(lds + RING_OFF, g, S, E);
    }
    GRID_BAR();

    if (PROBE_DUP & 4) {
        { pg8::Gemm g{WSB(WS_CQ), WSB(WS_WUQ), M, 768, 384, 384}; pg8::StaticOrder S; S.init(M, 768, G, bx);
          pg8::EpiQ E{WSB(WS_Q), WSF(WS_SSQA), WSF(WS_ROPE)};
          pg8::gemm_phase<pg8::EpiQ, pg8::StaticOrder, true, true>(lds + RING_OFF, g, S, E); }
        { pg8::Gemm g{WSB(WS_CKV), WSB(WS_WUKV), M, 1024, 256, 256}; pg8::StaticOrder S; S.init(M, 1024, G, bx);
          pg8::EpiKV E{WSB(WS_KV), WSF(WS_SSQA)};
          pg8::gemm_phase<pg8::EpiKV, pg8::StaticOrder, true, true>(lds + RING_OFF, g, S, E); }
        GRID_BAR();
    }
    {
        PHASE_IDS();
        bf16_t* gsc = (bf16_t*)args.out;
        for (int gid = bx * (NWAVES * 64) + tid; gid < 64 * 2048; gid += G * NWAVES * 64) gla2::g2_thread(gid, gsc, WSF(WS_SSQ1), gsc + 16 * MiB);
        if (PROBE_G & 2) { for (int gid = bx * (NWAVES * 64) + tid; gid < 64 * 2048; gid += G * NWAVES * 64) gla2::g2_thread(gid, gsc, WSF(WS_SSQ1), gsc + 16 * MiB); }
    }
    GRID_BAR();
    {
        PHASE_IDS();
        bf16_t* gsc = (bf16_t*)args.out;
        for (int c = bx * NWAVES + wave; c < 2048; c += G * NWAVES)
            gla2::g3_wave(c, gsc + 32 * MiB, gsc + 40 * MiB, WSB(WS_GV), gsc + 16 * MiB, IN_F(11), WSB(WS_ACAT), lds + RING_OFF + wave * gla2::WREG, lane);
        __syncthreads();
        if (PROBE_G & 4) { for (int c = bx * NWAVES + wave; c < 2048; c += G * NWAVES)
            gla2::g3_wave(c, gsc + 32 * MiB, gsc + 40 * MiB, WSB(WS_GV), gsc + 16 * MiB, IN_F(11), WSB(WS_S2), lds + RING_OFF + wave * gla2::WREG, lane);
            __syncthreads(); }
        const int myq = (int)(bar.x & 7u);
        for (int dq = 0; dq < 8; ++dq) {
            const int qj = (myq + dq) & 7;
            for (;;) {
                if (tid == 0) MISC[4] = __hip_atomic_fetch_add((unsigned*)(ctl + CW_Q + 64 * qj), 1u, RLX_AGENT);
                __syncthreads();
                const int it = (int)MISC[4];
                __syncthreads();
                if (it >= 128) break;
                att::attn_unit(it & 15, qj, 7 - (it >> 4), WSB(WS_Q), WSB(WS_KV), WSB(WS_SMALL), WSB(WS_ACAT), lds + RING_OFF);
            }
        }
    }
    GRID_BAR();

    if (PHMASK & 0x40) {
        pg8::Gemm g{WSB(WS_ACAT), WSB(WS_WCAT), M, 1024, 1024, 1024}; pg8::StaticOrder S; S.init(M, 1024, G, bx);
        pg8::EpiMerge E{WSB(WS_SMA), WSB(WS_SMB), WSB(WS_MERGED)};
        pg8::gemm_phase<pg8::EpiMerge, pg8::StaticOrder, true, true>(lds + RING_OFF, g, S, E);
    }
    GRID_BAR();

    if (PROBE_DUP & 16) {
        pg8::Gemm g{WSB(WS_ACAT), WSB(WS_WCAT), M, 1024, 1024, 1024}; pg8::StaticOrder S; S.init(M, 1024, G, bx);
        pg8::EpiMerge E{WSB(WS_SMA), WSB(WS_SMB), WSB(WS_MERGED)};
        pg8::gemm_phase<pg8::EpiMerge, pg8::StaticOrder, true, true>(lds + RING_OFF, g, S, E);
        GRID_BAR();
    }
    if (PHMASK & 0x80) {
        pg8::Gemm g{WSB(WS_MERGED), WSB(WS_WOUT), M, 1024, 1024, 1024}; pg8::StaticOrder S; S.init(M, 1024, G, bx);
        pg8::EpiX1 E{IN_F(0), args.out, WSB(WS_X1B), WSF(WS_SSQ1)};
        pg8::gemm_phase<pg8::EpiX1, pg8::StaticOrder, true, true>(lds + RING_OFF, g, S, E);
    }
    if (PHMASK & 0x100) {
        pg8::Gemm g{WSB(WS_PB), WSB(WS_WPLE), M, 1024, 256, 256}; pg8::StaticOrder S; S.init(M, 1024, G, bx);
        pg8::EpiE E{WSB(WS_E), WSF(WS_SSQE)};
        pg8::gemm_phase<pg8::EpiE, pg8::StaticOrder, true, true>(lds + RING_OFF, g, S, E);
    }
    GRID_BAR();

    if (PROBE_DUP & 32) {
        { pg8::Gemm g{WSB(WS_MERGED), WSB(WS_WOUT), M, 1024, 1024, 1024}; pg8::StaticOrder S; S.init(M, 1024, G, bx);
          pg8::EpiX1 E{IN_F(0), args.out, WSB(WS_X1B), WSF(WS_SSQ1)};
          pg8::gemm_phase<pg8::EpiX1, pg8::StaticOrder, true, true>(lds + RING_OFF, g, S, E); }
        { pg8::Gemm g{WSB(WS_PB), WSB(WS_WPLE), M, 1024, 256, 256}; pg8::StaticOrder S; S.init(M, 1024, G, bx);
          pg8::EpiE E{WSB(WS_E), WSF(WS_SSQE)};
          pg8::gemm_phase<pg8::EpiE, pg8::StaticOrder, true, true>(lds + RING_OFF, g, S, E); }
        GRID_BAR();
    }
    if (PROBE_DUP & 64) {
        pg8::Gemm g{WSB(WS_X1B), WSB(WS_WPLEG), M, 1024, 1024, 1024}; pg8::StaticOrder S; S.init(M, 1024, G, bx);
        pg8::EpiG E{WSF(WS_SSQ1), WSF(WS_SSQE), WSB(WS_E), IN_F(16), WSF(WS_ACAT), WSF(WS_SSQA)};
        pg8::gemm_phase<pg8::EpiG, pg8::StaticOrder, true, true>(lds + RING_OFF, g, S, E);
        GRID_BAR();
    }
    if (PHMASK & 0x200) {
        pg8::Gemm g{WSB(WS_X1B), WSB(WS_WPLEG), M, 1024, 1024, 1024}; pg8::StaticOrder S; S.init(M, 1024, G, bx);
        pg8::EpiG E{WSF(WS_SSQ1), WSF(WS_SSQE), WSB(WS_E), IN_F(16), args.out, WSF(WS_SSQ2)};
        pg8::gemm_phase<pg8::EpiG, pg8::StaticOrder, true, true>(lds + RING_OFF, g, S, E);
    }
    GRID_BAR();

    if (PHMASK & 0x400) {
        PHASE_IDS();
        const int gw = vcu * NWAVES + wave, NGW = G * NWAVES;
        const unsigned tmo = __hip_atomic_load((unsigned*)(ctl + CW_BAR) + XB_TMO, RLX_AGENT);
        const float* final_norm_g = IN_F(19); float* out = args.out; const float* SSQ2 = WSF(WS_SSQ2);
        f32x4 gg[4];
#pragma unroll
        for (int j = 0; j < 4; ++j) gg[j] = *((const GAS f32x4*)final_norm_g + lane + 64 * j);
        for (int m0 = gw * 4; m0 < M; m0 += NGW * 4) {
            f32x4 v[4][4]; float sv[4];
#pragma unroll
            for (int r = 0; r < 4; ++r) { sv[r] = (lane < 16) ? SSQ2[(size_t)(m0 + r) * 16 + lane] : 0.f; GAS f32x4* xr = (GAS f32x4*)(out + (size_t)(m0 + r) * D) + lane;
#pragma unroll
                for (int j = 0; j < 4; ++j) v[r][j] = xr[64 * j]; }
#pragma unroll
            for (int r = 0; r < 4; ++r) {
                float rs = rsq(wave_sum(sv[r]) * (1.f / D) + EPS);
                if (tmo) rs = __builtin_nanf("");
                GAS f32x4* xr = (GAS f32x4*)(out + (size_t)(m0 + r) * D) + lane;
#pragma unroll
                for (int j = 0; j < 4; ++j) xr[64 * j] = v[r][j] * rs * gg[j];
            }
        }
    }
}

extern "C" void kernel_launch(void* const* d_in, const int* in_sizes, int n_in, void* d_out, int out_size, void* d_ws, size_t ws_size, hipStream_t stream) {
    static int grid = 0;
    if (grid == 0) {
        if (n_in != 20 || in_sizes[0] != M * D || out_size != M * D || ws_size < WS_END) {
            fprintf(stderr, "kernel_launch: unexpected shapes (n_in %d, in0 %d, out %d, ws %zu; need ws >= %zu); nothing launched\n", n_in, n_in > 0 ? in_sizes[0] : -1, out_size, ws_size, (size_t)WS_END); grid = -1; return; }
        int dev = 0, cus = 0, per_cu = 0;
        if (hipGetDevice(&dev) != hipSuccess || hipDeviceGetAttribute(&cus, hipDeviceAttributeMultiprocessorCount, dev) != hipSuccess) { fprintf(stderr, "kernel_launch: device query failed\n"); grid = -1; return; }
        if (hipFuncSetAttribute((const void*)hybrid_fwd, hipFuncAttributeMaxDynamicSharedMemorySize, LDS_BYTES) != hipSuccess) { fprintf(stderr, "kernel_launch: hipFuncSetAttribute failed\n"); grid = -1; return; }
        if (hipOccupancyMaxActiveBlocksPerMultiprocessor(&per_cu, (const void*)hybrid_fwd, NWAVES * 64, LDS_BYTES) != hipSuccess || per_cu < 1)
            fprintf(stderr, "kernel_launch: note: occupancy query reports %d workgroups per CU\n", per_cu);
        (void)hipGetLastError();
        grid = cus;
    }
    if (grid < 0) return;
    if (hipMemsetAsync((char*)d_ws + WS_CTL, 0, CTL_ZERO_BYTES, stream) != hipSuccess) { fprintf(stderr, "kernel_launch: hipMemsetAsync failed\n"); return; }
    Args a{};
    for (int i = 0; i < 20; ++i) a.in[i] = d_in[i];
    a.out = (float*)d_out; a.ws = (unsigned char*)d_ws;
    hipLaunchKernelGGL(hybrid_fwd, dim3(grid), dim3(NWAVES * 64), LDS_BYTES, stream, a);
    const hipError_t le = hipPeekAtLastError();
    if (le != hipSuccess) fprintf(stderr, "kernel_launch: launch failed: %s\n", hipGetErrorName(le));
}
```
